# Optimizing an MI355X kernel written in HIP

```python
import jax, jax.numpy as jnp
from jax import lax
import numpy as np

D_MODEL = 1024
BATCH = 8
SEQ = 2048
DEPTH = 4

GRID_W = 64
CTX_LEN = 256
HEAD_DIM = 64
NA_HEADS = 4
GA_HEADS = 8
GA_KV_HEADS = 2
WA_HEADS = 4
WA_KV_HEADS = 2
D_MIX = (NA_HEADS + GA_HEADS + WA_HEADS) * HEAD_DIM
NA_WIN_ROWS = 8
NA_WIN_COLS = 16
WA_RADIUS = 128
Q_BLOCK = 128
D_FF = 2816
CONV_W = 3
ROPE_THETA = 10000.0
ROPE_PAIRS_PER_AXIS = HEAD_DIM // 4
EPS = 1e-6
N_MOD = 6

PROJ_SIZES = (NA_HEADS * HEAD_DIM, NA_HEADS * HEAD_DIM, NA_HEADS * HEAD_DIM,
              GA_HEADS * HEAD_DIM, GA_KV_HEADS * HEAD_DIM, GA_KV_HEADS * HEAD_DIM,
              WA_HEADS * HEAD_DIM, WA_KV_HEADS * HEAD_DIM, WA_KV_HEADS * HEAD_DIM)
PROJ_SPLITS = tuple(int(s) for s in np.cumsum(PROJ_SIZES)[:-1])
D_PROJ = int(sum(PROJ_SIZES))

kernel_name = "hymba_style_parallel_heads_dit_block"


def rmsnorm(x, g):
    xf = x.astype(jnp.float32)
    y = xf * lax.rsqrt(jnp.mean(xf * xf, axis=-1, keepdims=True) + EPS)
    return (y * g.astype(jnp.float32)).astype(x.dtype)


def modulate(h, shift, scale):
    return h * (1 + scale) + shift


def axial_rope(n_tokens):
    t = jnp.arange(n_tokens, dtype=jnp.int32)
    row = (t // GRID_W).astype(jnp.float32)
    col = (t % GRID_W).astype(jnp.float32)
    inv = ROPE_THETA ** (-jnp.arange(ROPE_PAIRS_PER_AXIS, dtype=jnp.float32) / ROPE_PAIRS_PER_AXIS)
    ang = jnp.concatenate([row[:, None] * inv, col[:, None] * inv], axis=-1)
    return jnp.cos(ang), jnp.sin(ang)


def apply_rope(x, cos, sin):
    xf = x.astype(jnp.float32)
    half = HEAD_DIM // 2
    x1, x2 = xf[..., :half], xf[..., half:]
    c = cos[None, :, None, :]
    s = sin[None, :, None, :]
    return jnp.concatenate([x1 * c - x2 * s, x1 * s + x2 * c], axis=-1).astype(x.dtype)


def dense_attn(q, k, v, sink=None):
    B, Lq, H, d = q.shape
    KVH = k.shape[2]
    G = H // KVH
    qg = q.reshape(B, Lq, KVH, G, d)
    s = jnp.einsum('bqkgd,bskd->bkgqs', qg, k).astype(jnp.float32) * (d ** -0.5)
    if sink is not None:
        sk = jnp.broadcast_to(sink.reshape(KVH, G)[None, :, :, None, None].astype(jnp.float32),
                              s.shape[:-1] + (1,))
        p = jax.nn.softmax(jnp.concatenate([s, sk], axis=-1), axis=-1)[..., :-1]
    else:
        p = jax.nn.softmax(s, axis=-1)
    o = jnp.einsum('bkgqs,bskd->bqkgd', p.astype(v.dtype), v)
    return o.reshape(B, Lq, H, d)


def neighbourhood_attn(q, k, v, kc, vc, rpb):
    B, S, H, d = q.shape
    rows = S // GRID_W
    kr = min(NA_WIN_ROWS, rows)
    kw = NA_WIN_COLS
    qg = q.reshape(B, rows, GRID_W, H, d)
    kg = k.reshape(B, rows, GRID_W, H, d)
    vg = v.reshape(B, rows, GRID_W, H, d)
    col = jnp.arange(GRID_W)
    col_idx = jnp.clip(col - kw // 2, 0, GRID_W - kw)[:, None] + jnp.arange(kw)[None]
    dc = col_idx - col[:, None]
    row = jnp.arange(rows)
    row_start = jnp.clip(row - kr // 2, 0, rows - kr)
    scale = d ** -0.5

    def one_row(args):
        r, rs, q_r = args
        k_nb = lax.dynamic_slice_in_dim(kg, rs, kr, axis=1)[:, :, col_idx]
        v_nb = lax.dynamic_slice_in_dim(vg, rs, kr, axis=1)[:, :, col_idx]
        dr = rs + jnp.arange(kr) - r
        bias = rpb[:, dr[:, None, None] + NA_WIN_ROWS - 1, dc[None] + NA_WIN_COLS - 1]
        bias = bias.transpose(0, 2, 1, 3).astype(jnp.float32)
        s_loc = jnp.einsum('bwhd,brwchd->bhwrc', q_r, k_nb).astype(jnp.float32) * scale + bias[None]
        s_loc = s_loc.reshape(B, H, GRID_W, kr * kw)
        s_ctx = jnp.einsum('bwhd,bchd->bhwc', q_r, kc).astype(jnp.float32) * scale
        p = jax.nn.softmax(jnp.concatenate([s_loc, s_ctx], axis=-1), axis=-1).astype(v.dtype)
        p_loc = p[..., :kr * kw].reshape(B, H, GRID_W, kr, kw)
        p_ctx = p[..., kr * kw:]
        return (jnp.einsum('bhwrc,brwchd->bwhd', p_loc, v_nb)
                + jnp.einsum('bhwc,bchd->bwhd', p_ctx, vc))

    o = lax.map(one_row, (row, row_start, qg.swapaxes(0, 1)))
    return o.swapaxes(0, 1).reshape(B, S, H, d)


def global_gqa(q, k, v, kc, vc):
    B, S, H, d = q.shape
    k_all = jnp.concatenate([k, kc], axis=1)
    v_all = jnp.concatenate([v, vc], axis=1)
    nb = S // Q_BLOCK
    qb = q.reshape(B, nb, Q_BLOCK, H, d).swapaxes(0, 1)
    o = lax.map(lambda qi: dense_attn(qi, k_all, v_all), qb)
    return o.swapaxes(0, 1).reshape(B, S, H, d)


def window_gqa(q, k, v, kc, vc, sink):
    B, S, H, d = q.shape
    KVH = k.shape[2]
    G = H // KVH
    nb = S // Q_BLOCK
    span = Q_BLOCK + 2 * WA_RADIUS
    pad = ((0, 0), (WA_RADIUS, WA_RADIUS), (0, 0), (0, 0))
    kp = jnp.pad(k, pad)
    vp = jnp.pad(v, pad)
    idx = (jnp.arange(nb) * Q_BLOCK)[:, None] + jnp.arange(span)[None]
    kb = kp[:, idx]
    vb = vp[:, idx]
    kpos = idx - WA_RADIUS
    qpos = jnp.arange(S).reshape(nb, Q_BLOCK)
    valid = ((jnp.abs(qpos[:, :, None] - kpos[:, None, :]) <= WA_RADIUS)
             & (kpos[:, None, :] >= 0) & (kpos[:, None, :] < S))
    qb = q.reshape(B, nb, Q_BLOCK, KVH, G, d)
    scale = d ** -0.5
    s_loc = jnp.einsum('bnqkgd,bnskd->bnkgqs', qb, kb).astype(jnp.float32) * scale
    s_loc = jnp.where(valid[None, :, None, None], s_loc, -jnp.inf)
    s_ctx = jnp.einsum('bnqkgd,bckd->bnkgqc', qb, kc).astype(jnp.float32) * scale
    s_sink = jnp.broadcast_to(sink.reshape(KVH, G)[None, None, :, :, None, None].astype(jnp.float32),
                              s_loc.shape[:-1] + (1,))
    p = jax.nn.softmax(jnp.concatenate([s_loc, s_ctx, s_sink], axis=-1), axis=-1).astype(v.dtype)
    L = kc.shape[1]
    o = (jnp.einsum('bnkgqs,bnskd->bnqkgd', p[..., :span], vb)
         + jnp.einsum('bnkgqc,bckd->bnqkgd', p[..., span:span + L], vc))
    return o.reshape(B, S, H, d)


def token_mix(h, hc, w_in, q_gain, k_gain, rpb, sink, w_out, cos, sin, with_ctx_out):
    B, S, _ = h.shape
    L = hc.shape[1]
    heads = lambda t: t.reshape(t.shape[:-1] + (-1, HEAD_DIM))
    qa, ka, va, qb, kb, vb, qw, kw, vw = [heads(t) for t in jnp.split(h @ w_in, PROJ_SPLITS, axis=-1)]
    qca, kca, vca, qcb, kcb, vcb, qcw, kcw, vcw = [heads(t) for t in jnp.split(hc @ w_in, PROJ_SPLITS, axis=-1)]
    qb = apply_rope(rmsnorm(qb, q_gain), cos, sin)
    kb = apply_rope(rmsnorm(kb, k_gain), cos, sin)
    kcb = rmsnorm(kcb, k_gain)
    qw = apply_rope(qw, cos, sin)
    kw = apply_rope(kw, cos, sin)
    oa = neighbourhood_attn(qa, ka, va, kca, vca, rpb)
    ob = global_gqa(qb, kb, vb, kcb, vcb)
    ow = window_gqa(qw, kw, vw, kcw, vcw, sink)
    out = jnp.concatenate([oa, ob, ow], axis=2).reshape(B, S, D_MIX) @ w_out
    if not with_ctx_out:
        return out, None
    oca = dense_attn(qca, kca, vca)
    ocb = dense_attn(rmsnorm(qcb, q_gain), kcb, vcb)
    ocw = dense_attn(qcw, kcw, vcw, sink)
    out_c = jnp.concatenate([oca, ocb, ocw], axis=2).reshape(B, L, D_MIX) @ w_out
    return out, out_c


def conv_ffn(h, w_up, conv_w, conv_b, w_down):
    a, b = jnp.split(h @ w_up, 2, axis=-1)
    n = a.shape[1]
    half = CONV_W // 2
    ap = jnp.pad(a, ((0, 0), (half, half), (0, 0)))
    a = sum(ap[:, j:j + n] * conv_w[j] for j in range(CONV_W)) + conv_b
    return (jax.nn.silu(a) * b) @ w_down


def setup_inputs(seed: int = 0) -> dict:
    key = jax.random.key(seed)
    ks = jax.random.split(key, 20)
    f32 = jnp.float32
    nrm = lambda k, shape, s: jax.random.normal(k, shape, f32) * s
    D = D_MODEL
    return {
        "x": nrm(ks[0], (BATCH, SEQ, D), 1.0),
        "c": nrm(ks[1], (BATCH, D), 1.0),
        "ctx": nrm(ks[2], (BATCH, CTX_LEN, D), 1.0),
        "c_ctx": nrm(ks[3], (D,), 1.0),
        "attn_norm": 1.0 + nrm(ks[4], (DEPTH, D), 0.05),
        "ffn_norm": 1.0 + nrm(ks[5], (DEPTH, D), 0.05),
        "w_mod": nrm(ks[6], (DEPTH, D, N_MOD * D), 0.5 * D ** -0.5),
        "b_mod": nrm(ks[7], (DEPTH, N_MOD * D), 0.02),
        "w_in": nrm(ks[8], (DEPTH, D, D_PROJ), D ** -0.5),
        "q_gain": 1.0 + nrm(ks[9], (DEPTH, HEAD_DIM), 0.05),
        "k_gain": 1.0 + nrm(ks[10], (DEPTH, HEAD_DIM), 0.05),
        "na_rpb": nrm(ks[11], (DEPTH, NA_HEADS, 2 * NA_WIN_ROWS - 1, 2 * NA_WIN_COLS - 1), 0.1),
        "wa_sink": nrm(ks[12], (DEPTH, WA_HEADS), 0.5),
        "w_out": nrm(ks[13], (DEPTH, D_MIX, D), D_MIX ** -0.5),
        "w_up": nrm(ks[14], (DEPTH, D, 2 * D_FF), D ** -0.5),
        "conv_w": nrm(ks[15], (DEPTH, CONV_W, D_FF), CONV_W ** -0.5),
        "conv_b": nrm(ks[16], (DEPTH, D_FF), 0.01),
        "w_down": nrm(ks[17], (DEPTH, D_FF, D), D_FF ** -0.5),
        "final_norm": 1.0 + nrm(ks[18], (D,), 0.05),
    }


def reference(x, c, ctx, c_ctx, attn_norm, ffn_norm, w_mod, b_mod, w_in, q_gain, k_gain,
              na_rpb, wa_sink, w_out, w_up, conv_w, conv_b, w_down, final_norm):
    S = x.shape[1]
    cos, sin = axial_rope(S)
    c_act = jax.nn.silu(c)
    cc_act = jax.nn.silu(c_ctx)
    cx = ctx
    for l in range(DEPTH):
        last = l == DEPTH - 1
        mx = (c_act @ w_mod[l] + b_mod[l])[:, None, :]
        mc = cc_act @ w_mod[l] + b_mod[l]
        sh_a, sc_a, gt_a, sh_f, sc_f, gt_f = jnp.split(mx, N_MOD, axis=-1)
        csh_a, csc_a, cgt_a, csh_f, csc_f, cgt_f = jnp.split(mc, N_MOD, axis=-1)
        h = modulate(rmsnorm(x, attn_norm[l]), sh_a, sc_a)
        hc = modulate(rmsnorm(cx, attn_norm[l]), csh_a, csc_a)
        o, oc = token_mix(h, hc, w_in[l], q_gain[l], k_gain[l], na_rpb[l], wa_sink[l], w_out[l],
                          cos, sin, not last)
        x = x + gt_a * o
        x = x + gt_f * conv_ffn(modulate(rmsnorm(x, ffn_norm[l]), sh_f, sc_f),
                                w_up[l], conv_w[l], conv_b[l], w_down[l])
        if not last:
            cx = cx + cgt_a * oc
            cx = cx + cgt_f * conv_ffn(modulate(rmsnorm(cx, ffn_norm[l]), csh_f, csc_f),
                                       w_up[l], conv_w[l], conv_b[l], w_down[l])
    return rmsnorm(x, final_norm)
```

```cpp
#include <hip/hip_runtime.h>
#include <hip/hip_cooperative_groups.h>
#include <cstdio>
#include <cstdint>
namespace cg = cooperative_groups;
namespace pg8 {
#define PG8_LAS __attribute__((address_space(3)))
typedef unsigned short bf16_t;
typedef short bf16x8 __attribute__((ext_vector_type(8)));
typedef float f32x4 __attribute__((ext_vector_type(4)));
typedef unsigned u32x4 __attribute__((ext_vector_type(4)));
constexpr int BM = 256, BK = 64, HALF = 128, HTB = HALF * BK * 2  , STAGE_BYTES = 8 * HTB, NXCD = 8, WGM = 8;

__host__ __device__ __forceinline__ int lds_byte(int r, int c) { const int st = (r >> 4) * 2 + (c >> 5), rr = r & 15, cc = c & 31, ob = rr * 64 + cc * 2; return st * 1024 + (ob ^ (((ob >> 9) & 1) << 5)); }
__host__ __device__ __forceinline__ void stage_rc(int b, int& R, int& C) { const int st = b / 1024, sb = b % 1024, swz = sb ^ (((sb >> 9) & 1) << 5); R = (st >> 1) * 16 + swz / 64; C = (st & 1) * 32 + (swz % 64) / 2; }
__host__ __device__ __forceinline__ int perm32(int rho) { const int n = rho >> 4, i = rho & 15; return 8 * (i >> 2) + 4 * n + (i & 3); }

struct Unit { int pm, pn, kt0, nt, part; };
struct Gemm { const bf16_t* A; const bf16_t* Bt; int M, N, K; };

struct StaticOrder {
    int nM, nN, nwg, G, c, ntf;
    __host__ __device__ void init(int M, int N, int G_, int c_, int K_ = 1024) { nM = M / BM; nN = N / BM; nwg = nM * nN; G = G_; c = c_; ntf = K_ / BK; }
    __host__ __device__ bool next(int i, Unit& u) const {
        const long L = (long)i * G + c; if (L >= nwg) return false;
        int wgid = (int)L; { const int q = nwg / NXCD, r = nwg % NXCD, xcd = wgid % NXCD, off = wgid / NXCD; wgid = (xcd < r ? xcd * (q + 1) : r * (q + 1) + (xcd - r) * q) + off; }
        const int wgm = (nM % NXCD == 0) ? nM / NXCD : WGM;
        const int nig = wgm * nN, gid = wgid / nig, fm = gid * wgm, gsz = (nM - fm) < wgm ? (nM - fm) : wgm;
        u.pm = fm + ((wgid % nig) % gsz); u.pn = (wgid % nig) / gsz; u.kt0 = 0; u.nt = ntf; u.part = 0; return true;
    }
    __device__ __forceinline__ void a_ready(const Unit&) const {}
    __device__ __forceinline__ void done(const Unit&) const {}
};


struct SplitCtxOrder {
    StaticOrder lat, all; bool split; int c, ntf;
    __host__ __device__ void init(int M, int K, int G, int c_) { c = c_; ntf = K / BK; split = (G == 256) && (M > 16384); lat.init(16384, 1024, G, c_, K); all.init(M, 1024, G, c_, K); }
    __host__ __device__ bool next(int i, Unit& u) const {
        Unit a; a.pm = 0; a.pn = 0; a.kt0 = 0; a.nt = ntf; a.part = 0; bool ok;
        if (!split) { Unit t; t.pm = 0; t.pn = 0; t.kt0 = 0; t.nt = ntf; t.part = 0; ok = all.next(i, t); a = t; }
        else if (i == 0) { Unit t; t.pm = 0; t.pn = 0; t.kt0 = 0; t.nt = ntf; t.part = 0; ok = lat.next(0, t); a = t; }
        else { ok = (i == 1) && (c < 128); const int cu = c >> 2, sl = c & 3;
            a.pm = 64 + (cu >> 2); a.pn = cu & 3; a.part = 1 + sl;
            a.kt0 = ntf == 16 ? 4 * sl : (sl == 0 ? 0 : sl == 1 ? 12 : sl == 2 ? 24 : 34); a.nt = ntf == 16 ? 4 : (sl < 2 ? 12 : 10); }
        u.pm = a.pm; u.pn = a.pn; u.kt0 = a.kt0; u.nt = a.nt; u.part = a.part; return ok;
    }
    __device__ __forceinline__ void a_ready(const Unit&) const {}
    __device__ __forceinline__ void done(const Unit&) const {}
};
__device__ __forceinline__ unsigned cvt_pk_bf16(float lo, float hi) { unsigned r; asm volatile("v_cvt_pk_bf16_f32 %0, %1, %2" : "=v"(r) : "v"(lo), "v"(hi)); return r; }
template <class Epi, class Sched, bool ALIGN_EPI = false, bool SP2 = false>
__device__ __forceinline__ void gemm_phase(PG8_LAS unsigned char* lds, const Gemm g, const Sched& S, const Epi& E) {
    int tid_l = threadIdx.x; asm volatile("" : "+v"(tid_l));
    const int tid = tid_l, wid = __builtin_amdgcn_readfirstlane(tid >> 6), lane = tid & 63, wr = wid >> 2, wc = wid & 3, fr = lane & 15, fq = lane >> 4;
    const int K = g.K;
    unsigned voffA[2], voffB[2];
#pragma unroll
    for (int i = 0; i < 2; ++i) { int R, C; stage_rc(tid * 16 + i * 8192, R, C); const int Rb = Epi::PERM ? ((R & ~31) + perm32(R & 31)) : R;
        voffA[i] = (unsigned)(R * K + C) * 2u; voffB[i] = (unsigned)(Rb * K + C) * 2u; }
    const size_t kstep = (size_t)(BK * 2);
    const size_t hstep = (size_t)HALF * K * 2;
    const size_t tstep = 2 * hstep;
    const unsigned ldsw = (unsigned)wid * 1024u;
    const int aoff = lds_byte(wr * 64 + fr, fq * 8), boff = lds_byte(wc * 32 + fr, fq * 8);
#define PG8_SA(b, h) (((b) * 2 + (h)) * HTB)
#define PG8_SB(b, h) ((4 + (b) * 2 + (h)) * HTB)
#define PG8_STAGE(bufoff, gbase, voff) do { _Pragma("unroll") for (int _i = 0; _i < 2; ++_i) \
        __builtin_amdgcn_global_load_lds((const unsigned*)((const char*)(gbase) + (voff)[_i]), (PG8_LAS unsigned*)(lds + (bufoff) + ldsw + _i * 8192), 16, 0, 0); } while (0)
#define PG8_LDA(dst, b, h) do { _Pragma("unroll") for (int m = 0; m < 4; ++m) _Pragma("unroll") for (int k = 0; k < 2; ++k) dst[m][k] = *(const PG8_LAS bf16x8*)(lds + PG8_SA(b, h) + aoff + m * 2048 + k * 1024); } while (0)
#define PG8_LDB(dst, b, h) do { _Pragma("unroll") for (int n = 0; n < 2; ++n) _Pragma("unroll") for (int k = 0; k < 2; ++k) dst[n][k] = *(const PG8_LAS bf16x8*)(lds + PG8_SB(b, h) + boff + n * 2048 + k * 1024); } while (0)
#define PG8_MMA(ai, bj, At, Bt) do { __builtin_amdgcn_s_setprio(1); _Pragma("unroll") for (int m = 0; m < 4; ++m) _Pragma("unroll") for (int n = 0; n < 2; ++n) _Pragma("unroll") for (int k = 0; k < 2; ++k) \
        acc[ai][bj][m][n] = __builtin_amdgcn_mfma_f32_16x16x32_bf16(Bt[n][k], At[m][k], acc[ai][bj][m][n], 0, 0, 0); __builtin_amdgcn_s_setprio(0); } while (0)
#define PG8_WAIT_V(n) asm volatile("s_waitcnt vmcnt(" #n ")" ::: "memory")
#define PG8_WAIT_L(n) asm volatile("s_waitcnt lgkmcnt(" #n ")" ::: "memory")
#define PG8_BAR __builtin_amdgcn_s_barrier()
#define PG8_SCHED __builtin_amdgcn_sched_barrier(0)
    Unit cur, nxt; int ui = 0;
    if (!S.next(0, cur)) return;
    int nt = cur.nt;
    f32x4 acc[2][2][4][2];
#pragma unroll
    for (int a = 0; a < 2; ++a)
#pragma unroll
        for (int b = 0; b < 2; ++b)
#pragma unroll
            for (int m = 0; m < 4; ++m)
#pragma unroll
                for (int n = 0; n < 2; ++n) acc[a][b][m][n] = (f32x4){0.f, 0.f, 0.f, 0.f};
    bf16x8 At[4][2], B0[2][2], B1[2][2];
    const char* cA = (const char*)g.A + (size_t)cur.pm * tstep + (size_t)cur.kt0 * kstep; const char* cB = (const char*)g.Bt + (size_t)cur.pn * tstep + (size_t)cur.kt0 * kstep;
    S.a_ready(cur);
    if constexpr (SP2) {
        PG8_STAGE(PG8_SB(0, 0), cB, voffB); PG8_STAGE(PG8_SB(0, 1), cB + hstep, voffB); PG8_STAGE(PG8_SA(0, 0), cA, voffA); PG8_STAGE(PG8_SA(0, 1), cA + hstep, voffA);
        if (wr == 1) PG8_BAR;
        PG8_WAIT_V(2); PG8_BAR;
        PG8_STAGE(PG8_SB(1, 0), cB + kstep, voffB); PG8_STAGE(PG8_SA(1, 0), cA + kstep, voffA); PG8_STAGE(PG8_SB(1, 1), cB + hstep + kstep, voffB);
        PG8_WAIT_V(6); PG8_BAR;
    } else {
        PG8_STAGE(PG8_SB(0, 0), cB, voffB); PG8_STAGE(PG8_SA(0, 0), cA, voffA); PG8_STAGE(PG8_SB(0, 1), cB + hstep, voffB); PG8_STAGE(PG8_SA(0, 1), cA + hstep, voffA);
        if (wr == 1) PG8_BAR;
        PG8_WAIT_V(4); PG8_BAR;
        PG8_STAGE(PG8_SB(1, 0), cB + kstep, voffB); PG8_STAGE(PG8_SA(1, 0), cA + kstep, voffA); PG8_STAGE(PG8_SB(1, 1), cB + hstep + kstep, voffB);
        PG8_WAIT_V(6); PG8_BAR;
    }
    for (;;) {
        const bool has_next = S.next(ui + 1, nxt);
        const char* nA = has_next ? (const char*)g.A + (size_t)nxt.pm * tstep + (size_t)nxt.kt0 * kstep : cA; const char* nB = has_next ? (const char*)g.Bt + (size_t)nxt.pn * tstep + (size_t)nxt.kt0 * kstep : cB;
        for (int t = 0; t < nt; t += 2) {
            const bool last = (t == nt - 2);
            const char* a1 = cA + (size_t)(t + 1) * kstep;
            const char* a2 = last ? nA : cA + (size_t)(t + 2) * kstep; const char* b2 = last ? nB : cB + (size_t)(t + 2) * kstep;
            const char* a3 = a2 + kstep; const char* b3 = b2 + kstep;
            if (last && has_next) S.a_ready(nxt);
            if constexpr (SP2) {
            PG8_LDB(B0, 0, 0); PG8_LDB(B1, 0, 1); PG8_SCHED; PG8_LDA(At, 0, 0); PG8_STAGE(PG8_SA(1, 1), a1 + hstep, voffA);
            PG8_WAIT_V(8); PG8_WAIT_L(0); PG8_BAR; PG8_MMA(0, 0, At, B0); PG8_MMA(0, 1, At, B1); PG8_BAR; PG8_SCHED;
            PG8_LDA(At, 0, 1); PG8_STAGE(PG8_SB(0, 0), b2, voffB); PG8_STAGE(PG8_SB(0, 1), b2 + hstep, voffB); PG8_STAGE(PG8_SA(0, 0), a2, voffA);
            PG8_WAIT_V(8); PG8_WAIT_L(0); PG8_BAR; PG8_MMA(1, 0, At, B0); PG8_MMA(1, 1, At, B1); PG8_BAR; PG8_SCHED;
            PG8_LDB(B0, 1, 0); PG8_LDB(B1, 1, 1); PG8_SCHED; PG8_LDA(At, 1, 0); PG8_STAGE(PG8_SA(0, 1), a2 + hstep, voffA);
            PG8_WAIT_V(8); PG8_WAIT_L(0); PG8_BAR; PG8_MMA(0, 0, At, B0); PG8_MMA(0, 1, At, B1); PG8_BAR; PG8_SCHED;
            PG8_LDA(At, 1, 1); PG8_STAGE(PG8_SB(1, 0), b3, voffB); PG8_STAGE(PG8_SB(1, 1), b3 + hstep, voffB); PG8_STAGE(PG8_SA(1, 0), a3, voffA);
            PG8_WAIT_V(8); PG8_WAIT_L(0); PG8_BAR; PG8_MMA(1, 0, At, B0); PG8_MMA(1, 1, At, B1); PG8_BAR; PG8_SCHED;
            } else {
            PG8_LDB(B0, 0, 0); PG8_SCHED; PG8_LDA(At, 0, 0); PG8_STAGE(PG8_SA(1, 1), a1 + hstep, voffA);
            PG8_WAIT_L(8); PG8_BAR; PG8_WAIT_L(0); PG8_MMA(0, 0, At, B0); PG8_BAR; PG8_SCHED;
            PG8_LDB(B1, 0, 1); PG8_STAGE(PG8_SB(0, 0), b2, voffB);
            PG8_BAR; PG8_WAIT_L(0); PG8_MMA(0, 1, At, B1); PG8_BAR;
            PG8_LDA(At, 0, 1); PG8_STAGE(PG8_SA(0, 0), a2, voffA);
            PG8_BAR; PG8_WAIT_L(0); PG8_MMA(1, 0, At, B0); PG8_BAR; PG8_SCHED;
            PG8_STAGE(PG8_SB(0, 1), b2 + hstep, voffB);
            PG8_WAIT_V(6); PG8_BAR; PG8_MMA(1, 1, At, B1); PG8_BAR;
            PG8_LDB(B0, 1, 0); PG8_SCHED; PG8_LDA(At, 1, 0); PG8_STAGE(PG8_SA(0, 1), a2 + hstep, voffA);
            PG8_WAIT_L(8); PG8_BAR; PG8_WAIT_L(0); PG8_MMA(0, 0, At, B0); PG8_BAR; PG8_SCHED;
            PG8_LDB(B1, 1, 1); PG8_STAGE(PG8_SB(1, 0), b3, voffB);
            PG8_BAR; PG8_WAIT_L(0); PG8_MMA(0, 1, At, B1); PG8_BAR;
            PG8_LDA(At, 1, 1); PG8_STAGE(PG8_SA(1, 0), a3, voffA);
            PG8_BAR; PG8_WAIT_L(0); PG8_MMA(1, 0, At, B0); PG8_BAR; PG8_SCHED;
            PG8_STAGE(PG8_SB(1, 1), b3 + hstep, voffB);
            PG8_WAIT_V(6); PG8_BAR; PG8_MMA(1, 1, At, B1); PG8_BAR;
            }
        }
        if constexpr (ALIGN_EPI) { if (wr == 0) PG8_BAR; }
        if constexpr (!Epi::AFTER_DRAIN) { E(acc, cur, wr, wc, fr, fq); S.done(cur); }
        if (!has_next) break;
#pragma unroll
        for (int a = 0; a < 2; ++a)
#pragma unroll
            for (int b = 0; b < 2; ++b)
#pragma unroll
                for (int m = 0; m < 4; ++m)
#pragma unroll
                    for (int n = 0; n < 2; ++n) acc[a][b][m][n] = (f32x4){0.f, 0.f, 0.f, 0.f};
        cur = nxt; cA = nA; cB = nB; ++ui; nt = cur.nt;
        if constexpr (ALIGN_EPI) { if (wr == 1) PG8_BAR; }
    }
    PG8_WAIT_V(0);
    if constexpr (!ALIGN_EPI) { if (wr == 0) PG8_BAR; }
    PG8_BAR;
    if constexpr (Epi::AFTER_DRAIN) { E.fused(acc, cur, wr, wc, fr, fq, lds, wid, lane); S.done(cur); }
#undef PG8_SA
#undef PG8_SB
#undef PG8_STAGE
#undef PG8_LDA
#undef PG8_LDB
#undef PG8_MMA
#undef PG8_WAIT_V
#undef PG8_WAIT_L
#undef PG8_BAR
#undef PG8_SCHED
}
}

#define GAS __attribute__((address_space(1)))
#define LAS __attribute__((address_space(3)))
typedef unsigned short bf16_t;
typedef float f32x4 __attribute__((ext_vector_type(4)));
typedef float f32x16 __attribute__((ext_vector_type(16)));
typedef short bf16x8 __attribute__((ext_vector_type(8)));
typedef unsigned u32x4 __attribute__((ext_vector_type(4)));
typedef unsigned u32x2 __attribute__((ext_vector_type(2)));
using pg8::cvt_pk_bf16;

constexpr int DM = 1024, NB = 8, SEQ = 2048, CTXL = 256, DEPTH = 4;
constexpr int ML = NB * SEQ, MC = NB * CTXL, MT = ML + MC;
constexpr int DPROJ = 2048, DFF = 2816, NMOD = 6144, KT = 36;
constexpr float EPS = 1e-6f;
constexpr float LOG2E = 1.4426950408889634f;
constexpr float QSCALE = 0.125f * LOG2E;
constexpr float NEGBIG = -1e30f;

constexpr size_t MiB = 1u << 20;
constexpr size_t WS_CTL = 0, WS_WIN = 1 * MiB, WS_WOUT = 17 * MiB, WS_WUP = 25 * MiB, WS_WDN = 69 * MiB, WS_MOD = 91 * MiB, WS_ROPE = 92 * MiB,
                 WS_X = 93 * MiB, WS_H = 165 * MiB, WS_EDGE = 201 * MiB, WS_Q = 221 * MiB, WS_O = 257 * MiB, WS_K = 293 * MiB, WS_V = 311 * MiB,
                 WS_HID = 221 * MiB, WS_PB = 329 * MiB, WS_END = 345 * MiB;
constexpr size_t WS_GAIN = WS_MOD + 917504, WS_CP = WS_ROPE + 524288;
constexpr int CP_AN = 0, CP_FN = 4096, CP_RPB = 8192, CP_SINK = 15632, CP_FIN = 15648, CP_CONV = 16896;
constexpr int LDS_BYTES = 147456;

#define LDS_WAIT() asm volatile("s_waitcnt lgkmcnt(0)" ::: "memory")

#define XB_TMO      128
#define XB_XCNT(j)  (256  + 64 * (j))
#define XB_XSUB(j)  (1280 + 64 * (j))
#define XB_XGEN(j)  (2304 + 64 * (j))
#define XB_TOP      3328
#define XB_TOPGEN   3392
#define XCD_BAR_WORDS 3456
#define XB_SPIN_CAP (1u << 18)

__device__ __forceinline__ unsigned xb_ld(unsigned* p)              { return __hip_atomic_load(p, __ATOMIC_RELAXED, __HIP_MEMORY_SCOPE_AGENT); }
__device__ __forceinline__ unsigned xb_add(unsigned* p, unsigned v) { return __hip_atomic_fetch_add(p, v, __ATOMIC_RELAXED, __HIP_MEMORY_SCOPE_AGENT); }
__device__ __forceinline__ unsigned xb_xcc_id() { return (unsigned)__builtin_amdgcn_s_getreg((3 << 11) | 20) & 0xFu; }
#define XB_SPIN(cond, bar) do { unsigned _sp = 0; while (cond) { __builtin_amdgcn_s_sleep(1); \
    if ((++_sp & 255u) == 0u) { if (xb_ld(&(bar)[XB_TMO])) break; if (_sp > XB_SPIN_CAP) { atomicAdd(&(bar)[XB_TMO], 1u); break; } } } } while (0)

struct XcdBarrier {
    unsigned* bar; unsigned x;
    volatile LAS unsigned* st;
};

__device__ __forceinline__ XcdBarrier xcd_barrier_post(unsigned* bar, volatile LAS unsigned* st) {
    XcdBarrier b; b.bar = bar; b.x = xb_xcc_id(); b.st = st;
    if (threadIdx.x == 0) (void)xb_add(&bar[XB_XCNT(b.x)], 1u);
    return b;
}
__device__ __forceinline__ void xcd_barrier_complete(unsigned* bar, unsigned x, unsigned& nloc, unsigned& nx) {
    const unsigned G = gridDim.x * gridDim.y * gridDim.z;
    unsigned sum, cnt, mine, sp = 0u;
    for (;;) {
        sum = 0u; cnt = 0u; mine = 0u;
#pragma unroll
        for (unsigned j = 0; j < 16; ++j) { const unsigned c = xb_ld(&bar[XB_XCNT(j)]); sum += c; cnt += (c > 0u) ? 1u : 0u; mine = (j == x) ? c : mine; }
        if (sum == G) break;
        __builtin_amdgcn_s_sleep(1);
        if ((++sp & 255u) == 0u) { if (xb_ld(&bar[XB_TMO])) break; if (sp > XB_SPIN_CAP) { atomicAdd(&bar[XB_TMO], 1u); break; } }
    }
    nloc = mine > 0u ? mine : 1u; nx = cnt > 0u ? cnt : 1u;
}

__device__ __forceinline__ void xcd_barrier(const XcdBarrier& b) {
    asm volatile("s_waitcnt vmcnt(0)" ::: "memory");
    __syncthreads();
    if (threadIdx.x == 0) {
        unsigned* bar = b.bar;
        __builtin_amdgcn_s_waitcnt(0);
        unsigned nloc = b.st[0], nx = b.st[1];
        if (nloc == 0u) { xcd_barrier_complete(bar, b.x, nloc, nx); b.st[0] = nloc; b.st[1] = nx; }
        const unsigned old = xb_add(&bar[XB_XSUB(b.x)], 1u);
        const unsigned gen = old / nloc;
        if (old + 1u == (gen + 1u) * nloc) {
            __builtin_amdgcn_fence(__ATOMIC_RELEASE, "agent");
            asm volatile("s_waitcnt vmcnt(0)" ::: "memory");
            const unsigned og = xb_add(&bar[XB_TOP], 1u);
            const unsigned tg = og / nx;
            if (og + 1u == (tg + 1u) * nx) xb_add(&bar[XB_TOPGEN], 1u);
            else XB_SPIN(xb_ld(&bar[XB_TOPGEN]) == tg, bar);
            __builtin_amdgcn_fence(__ATOMIC_ACQUIRE, "agent");
            xb_add(&bar[XB_XGEN(b.x)], 1u);
            asm volatile("s_waitcnt vmcnt(0)" ::: "memory");
        } else {
            XB_SPIN(xb_ld(&bar[XB_XGEN(b.x)]) == gen, bar);
            __builtin_amdgcn_fence(__ATOMIC_ACQUIRE, "agent");
            asm volatile("s_waitcnt vmcnt(0)" ::: "memory");
        }
    }
    __syncthreads();
}

struct Args { const float* in[19]; float* out; unsigned char* ws; };

__device__ __forceinline__ float wave_sum(float v) {
#pragma unroll
    for (int o = 1; o < 64; o <<= 1) v += __shfl_xor(v, o);
    return v;
}
__device__ __forceinline__ float silu_f(float x) { return x * __builtin_amdgcn_rcpf(1.0f + __builtin_amdgcn_exp2f(-x * LOG2E)); }
__device__ __forceinline__ float dpp_ror1(float x)  { return __builtin_bit_cast(float, __builtin_amdgcn_update_dpp(0, __builtin_bit_cast(int, x), 0x121, 0xf, 0xf, false)); }
__device__ __forceinline__ float dpp_ror15(float x) { return __builtin_bit_cast(float, __builtin_amdgcn_update_dpp(0, __builtin_bit_cast(int, x), 0x12F, 0xf, 0xf, false)); }

__device__ __forceinline__ void tr_item(const float* W, int K, int N, bf16_t* WT, int k0, int src_n0, int dst_n0, LAS float* scr, int lane) {
#pragma unroll 8
    for (int i = 0; i < 32; ++i) { const int kk = 2 * i + (lane >> 5); scr[kk * 33 + (lane & 31)] = W[(size_t)(k0 + kk) * N + src_n0 + (lane & 31)]; }
    LDS_WAIT(); asm volatile("" ::: "memory");
    const int c = lane & 7;
#pragma unroll
    for (int j = 0; j < 4; ++j) { const int n = (lane >> 3) + 8 * j; const LAS float* s = scr + (8 * c) * 33 + n;
        u32x4 o; o.x = cvt_pk_bf16(s[0 * 33], s[1 * 33]); o.y = cvt_pk_bf16(s[2 * 33], s[3 * 33]); o.z = cvt_pk_bf16(s[4 * 33], s[5 * 33]); o.w = cvt_pk_bf16(s[6 * 33], s[7 * 33]);
        *(u32x4*)(WT + (size_t)(dst_n0 + n) * K + k0 + 8 * c) = o; }
    LDS_WAIT(); asm volatile("" ::: "memory");
}

__device__ __forceinline__ void prologue(const Args& a, LAS unsigned char* lds) {
    const int tid = threadIdx.x, lane = tid & 63, wave = tid >> 6;
    unsigned char* ws = a.ws;
    {
        LAS float* scr = (LAS float*)(lds + 49152 + wave * 8704);
        const int gw = blockIdx.x * 8 + wave, NGW = gridDim.x * 8;
        constexpr int I_IN = 16 * 64, I_OUT = 16 * 32, I_UP = 16 * 176, I_DN = 44 * 32, I_L = I_IN + I_OUT + I_UP + I_DN;
        for (int it = gw; it < DEPTH * I_L; it += NGW) {
            const int l = it / I_L; int r = it % I_L;
            if (r < I_IN) { const int kb = r / 64, nb = r % 64, pn = nb >> 3, p0 = (nb & 7) * 32;
                const int src = 256 * pn + 64 * ((p0 & 127) >> 5) + 32 * (p0 >> 7);
                tr_item(a.in[8] + (size_t)l * DM * DPROJ, DM, DPROJ, (bf16_t*)(ws + WS_WIN) + (size_t)l * DPROJ * DM, kb * 64, src, nb * 32, scr, lane); continue; }
            r -= I_IN;
            if (r < I_OUT) { const int kb = r / 32, nb = r % 32;
                tr_item(a.in[13] + (size_t)l * DM * DM, DM, DM, (bf16_t*)(ws + WS_WOUT) + (size_t)l * DM * DM, kb * 64, nb * 32, nb * 32, scr, lane); continue; }
            r -= I_OUT;
            if (r < I_UP) { const int kb = r / 176, nb = r % 176, pn = nb >> 3, p0 = (nb & 7) * 32;
                const int src = p0 < 128 ? 128 * pn + p0 : DFF + 128 * pn + p0 - 128;
                tr_item(a.in[14] + (size_t)l * DM * 2 * DFF, DM, 2 * DFF, (bf16_t*)(ws + WS_WUP) + (size_t)l * 2 * DFF * DM, kb * 64, src, nb * 32, scr, lane); continue; }
            r -= I_UP;
            { const int kb = r / 32, nb = r % 32;
                tr_item(a.in[17] + (size_t)l * DFF * DM, DFF, DM, (bf16_t*)(ws + WS_WDN) + (size_t)l * DM * DFF, kb * 64, nb * 32, nb * 32, scr, lane); }
        }
    }
    {
        float* cosT = (float*)(ws + WS_ROPE); float* sinT = cosT + SEQ * 32;
        for (int idx = blockIdx.x * 512 + tid; idx < SEQ * 32; idx += gridDim.x * 512) {
            const int t = idx >> 5, i = idx & 31, p = i & 15, pa = p >> 2, pb = p & 3;
            const int pos = i < 16 ? (t >> 6) : (t & 63);
            const double ia = pa == 0 ? 1.0 : pa == 1 ? 0.1 : pa == 2 ? 0.01 : 0.001;
            const double ib = pb == 0 ? 1.0 : pb == 1 ? 0.5623413251903491 : pb == 2 ? 0.31622776601683794 : 0.17782794100389228;
            const double x = (double)pos * (ia * ib);
            const double kq = __builtin_rint(x * 0.6366197723675814);
            const double r = (x - kq * 1.5707963267948966) - kq * 6.123233995736766e-17;
            const double r2 = r * r;
            const double sn = r * (1.0 + r2 * (-1.0 / 6 + r2 * (1.0 / 120 + r2 * (-1.0 / 5040 + r2 * (1.0 / 362880 + r2 * (-1.0 / 39916800 + r2 * (1.0 / 6227020800.0)))))));
            const double cs = 1.0 + r2 * (-0.5 + r2 * (1.0 / 24 + r2 * (-1.0 / 720 + r2 * (1.0 / 40320 + r2 * (-1.0 / 3628800 + r2 * (1.0 / 479001600 + r2 * (-1.0 / 87178291200.0)))))));
            const int q = ((int)kq) & 3;
            const double c = q == 0 ? cs : q == 1 ? -sn : q == 2 ? -cs : sn;
            const double s = q == 0 ? sn : q == 1 ? cs : q == 2 ? -sn : -cs;
            cosT[idx] = (float)c; sinT[idx] = (float)s;
        }
    }
    if (blockIdx.x == 0) { float* gains = (float*)(ws + WS_GAIN); const int l = tid >> 7, w = (tid >> 6) & 1, d = tid & 63; gains[tid] = w ? a.in[10][l * 64 + d] : a.in[9][l * 64 + d];
        if (tid < DEPTH) { float mq = 0.f, mk = 0.f; for (int d2 = 0; d2 < 64; ++d2) { mq = fmaxf(mq, fabsf(a.in[9][tid * 64 + d2])); mk = fmaxf(mk, fabsf(a.in[10][tid * 64 + d2])); }
            gains[512 + tid] = 64.0f * mq * mk * QSCALE * 1.02f; } }
    { float* cp = (float*)(ws + WS_CP); const int gt = blockIdx.x * 512 + tid, NT = gridDim.x * 512;
      for (int i = gt; i < 4096; i += NT) { cp[CP_AN + i] = a.in[4][i]; cp[CP_FN + i] = a.in[5][i]; }
      for (int i = gt; i < 7440; i += NT) cp[CP_RPB + i] = a.in[11][i];
      for (int i = gt; i < 16; i += NT) cp[CP_SINK + i] = a.in[12][i];
      for (int i = gt; i < 1024; i += NT) cp[CP_FIN + i] = a.in[18][i];
      for (int i = gt; i < DEPTH * 4 * DFF; i += NT) { const int l = i / (4 * DFF), r = i % (4 * DFF); cp[CP_CONV + i] = r < 3 * DFF ? a.in[15][l * 3 * DFF + r] : a.in[16][l * DFF + r - 3 * DFF]; } }
    {
        LAS float* ca = (LAS float*)lds;
        LAS float* red = (LAS float*)(lds + 36864);
        for (int idx = tid; idx < 9 * DM; idx += 512) { const int r = idx >> 10, k = idx & 1023; const float v = r < 8 ? a.in[1][r * DM + k] : a.in[3][k]; ca[idx] = v / (1.0f + expf(-v)); }
        __syncthreads();
        float* mod = (float*)(ws + WS_MOD);
        const int c4 = lane & 7, kr = lane >> 3;
        for (int item = blockIdx.x; item < DEPTH * 192; item += gridDim.x) {
            const int l = item / 192, col0 = (item % 192) * 32;
            f32x4 acc[9];
#pragma unroll
            for (int r = 0; r < 9; ++r) acc[r] = (f32x4){0.f, 0.f, 0.f, 0.f};
            const float* wp = a.in[6] + ((size_t)l * DM + wave * 128 + kr) * NMOD + col0 + 4 * c4;
#pragma unroll 4
            for (int i = 0; i < 16; ++i) { const f32x4 wv = *(const f32x4*)(wp + (size_t)i * 8 * NMOD); const int k = wave * 128 + 8 * i + kr;
#pragma unroll
                for (int r = 0; r < 9; ++r) acc[r] += ca[r * DM + k] * wv; }
#pragma unroll
            for (int r = 0; r < 9; ++r)
#pragma unroll
                for (int j = 0; j < 4; ++j) { float v = acc[r][j]; v += __shfl_xor(v, 8); v += __shfl_xor(v, 16); v += __shfl_xor(v, 32); acc[r][j] = v; }
            if (kr == 0) {
#pragma unroll
                for (int r = 0; r < 9; ++r) *(LAS f32x4*)(red + (wave * 9 + r) * 32 + 4 * c4) = acc[r]; }
            __syncthreads();
            if (tid < 288) { const int r = tid >> 5, ci = tid & 31; float s = a.in[7][l * NMOD + col0 + ci];
#pragma unroll
                for (int w = 0; w < 8; ++w) s += red[(w * 9 + r) * 32 + ci];
                mod[((size_t)l * 9 + r) * NMOD + col0 + ci] = s; }
            __syncthreads();
        }
    }
}

__device__ __forceinline__ void norm_phase(const float* srcL, const float* srcC, float* xcopy, const float* g, const float* modl, int shoff, int scoff, bf16_t* H, int nrows, const bf16_t* PB = nullptr) {
    int tid_l = threadIdx.x; asm volatile("" : "+v"(tid_l));
    const int lane = tid_l & 63, wave = tid_l >> 6;
    const int gw = blockIdx.x * 8 + wave, NGW = gridDim.x * 8;
    for (int row = gw; row < nrows; row += NGW) {
        const float* src = row < ML ? srcL + (size_t)row * DM : srcC + (size_t)(row - ML) * DM;
        const int bidx = row < ML ? row >> 11 : 8;
        const float* mr = modl + (size_t)bidx * NMOD;
        f32x4 v[4]; float ss = 0.f;
#pragma unroll
        for (int j = 0; j < 4; ++j) { v[j] = *(const f32x4*)(src + 4 * (64 * j + lane));
            if (PB && row >= ML) { const size_t o = (size_t)(row - ML) * DM + 4 * (64 * j + lane);
#pragma unroll
                for (int sl = 0; sl < 4; ++sl) { const u32x2 w = *(const u32x2*)(PB + (size_t)sl * MC * DM + o);
                    v[j].x += __uint_as_float(w.x << 16); v[j].y += __uint_as_float(w.x & 0xffff0000u); v[j].z += __uint_as_float(w.y << 16); v[j].w += __uint_as_float(w.y & 0xffff0000u); }
                *(f32x4*)(const_cast<float*>(src) + 4 * (64 * j + lane)) = v[j]; }
            ss += (v[j].x * v[j].x + v[j].y * v[j].y) + (v[j].z * v[j].z + v[j].w * v[j].w); }
        const float rstd = 1.0f / sqrtf(wave_sum(ss) * (1.0f / DM) + EPS);
#pragma unroll
        for (int j = 0; j < 4; ++j) { const int c = 4 * (64 * j + lane);
            const f32x4 gv = *(const f32x4*)(g + c), sc = *(const f32x4*)(mr + scoff + c), sh = *(const f32x4*)(mr + shoff + c);
            const f32x4 y = (v[j] * rstd) * gv * (1.0f + sc) + sh;
            u32x2 o; o.x = cvt_pk_bf16(y.x, y.y); o.y = cvt_pk_bf16(y.z, y.w);
            *(u32x2*)(H + (size_t)row * DM + c) = o;
            if (xcopy && (row >= ML || gridDim.x != 256)) *(f32x4*)(xcopy + (size_t)row * DM + c) = v[j]; }
    }
}
__device__ __forceinline__ void final_norm_phase(const float* X, const float* g, float* out) {
    const int lane = threadIdx.x & 63, wave = threadIdx.x >> 6;
    const int gw = blockIdx.x * 8 + wave, NGW = gridDim.x * 8;
    for (int row = gw; row < ML; row += NGW) {
        const float* src = X + (size_t)row * DM;
        f32x4 v[4]; float ss = 0.f;
#pragma unroll
        for (int j = 0; j < 4; ++j) { v[j] = *(const f32x4*)(src + 4 * (64 * j + lane)); ss += (v[j].x * v[j].x + v[j].y * v[j].y) + (v[j].z * v[j].z + v[j].w * v[j].w); }
        const float rstd = 1.0f / sqrtf(wave_sum(ss) * (1.0f / DM) + EPS);
#pragma unroll
        for (int j = 0; j < 4; ++j) { const int c = 4 * (64 * j + lane); const f32x4 gv = *(const f32x4*)(g + c);
            *(f32x4*)(out + (size_t)row * DM + c) = (v[j] * rstd) * gv; }
    }
}

struct EpiQKV {
    static constexpr bool PERM = true, AFTER_DRAIN = false;
    bf16_t* Q; bf16_t* Kf; bf16_t* Vf; const float* gains; const float* cosT; const float* sinT;
    __device__ __forceinline__ void operator()(const pg8::f32x4 (&acc)[2][2][4][2], const pg8::Unit& u, int wr_, int wc_, int fr_, int fq_) const {
        int wr = wr_, wc = wc_, fr = fr_, fq = fq_; asm volatile("" : "+s"(wr), "+s"(wc), "+v"(fr), "+v"(fq));
        const int pn = u.pn, pm = u.pm;
        int kind = 0, head = 0, nrm = 0, rope = 0;
        if (pn == 0) { kind = 0; head = wc; }
        else if (pn == 1) { kind = 1; head = wc; }
        else if (pn == 2) { kind = 2; head = wc; }
        else if (pn == 3 || pn == 4) { kind = 0; head = 4 * (pn - 2) + wc; nrm = 1; rope = 1; }
        else if (pn == 5) { if (wc < 2) { kind = 1; head = 4 + wc; nrm = 2; rope = 1; } else { kind = 2; head = 2 + wc; } }
        else if (pn == 6) { kind = 0; head = 12 + wc; rope = 1; }
        else { if (wc < 2) { kind = 1; head = 6 + wc; rope = 1; } else { kind = 2; head = 4 + wc; } }
        const bool latent = pm < 64;
        const int b = latent ? (pm >> 3) : (pm - 64);
        const int tile0 = latent ? (pm & 7) * 4 : 32;
        const int s0 = latent ? (pm & 7) * 256 : 0;
        if (!latent) rope = 0;
        const float* gp = gains + (nrm == 2 ? 64 : 0) + 8 * fq;
#pragma unroll
        for (int ai = 0; ai < 2; ++ai)
#pragma unroll
            for (int m = 0; m < 4; ++m) {
                const int rl = 128 * ai + 64 * wr + 16 * m + fr;
                f32x4 v[2][2];
#pragma unroll
                for (int bj = 0; bj < 2; ++bj)
#pragma unroll
                    for (int n = 0; n < 2; ++n) v[bj][n] = acc[ai][bj][m][n];
                if (nrm) {
                    float ss = 0.f;
#pragma unroll
                    for (int bj = 0; bj < 2; ++bj)
#pragma unroll
                        for (int n = 0; n < 2; ++n) ss += (v[bj][n].x * v[bj][n].x + v[bj][n].y * v[bj][n].y) + (v[bj][n].z * v[bj][n].z + v[bj][n].w * v[bj][n].w);
                    ss += __shfl_xor(ss, 16); ss += __shfl_xor(ss, 32);
                    const float rs = 1.0f / sqrtf(ss * (1.0f / 64.0f) + EPS);
#pragma unroll
                    for (int bj = 0; bj < 2; ++bj)
#pragma unroll
                        for (int n = 0; n < 2; ++n) v[bj][n] = (v[bj][n] * rs) * *(const f32x4*)(gp + 32 * bj + 4 * n);
                }
                if (rope) {
                    const int s = s0 + rl;
#pragma unroll
                    for (int n = 0; n < 2; ++n) {
                        const f32x4 cs = *(const f32x4*)(cosT + s * 32 + 8 * fq + 4 * n), sn = *(const f32x4*)(sinT + s * 32 + 8 * fq + 4 * n);
                        const f32x4 x1 = v[0][n], x2 = v[1][n];
                        v[0][n] = x1 * cs - x2 * sn; v[1][n] = x1 * sn + x2 * cs; }
                }
                if (kind == 0) {
#pragma unroll
                    for (int bj = 0; bj < 2; ++bj) { const f32x4 a0 = v[bj][0] * QSCALE, a1 = v[bj][1] * QSCALE;
                        u32x4 w; w.x = cvt_pk_bf16(a0.x, a0.y); w.y = cvt_pk_bf16(a0.z, a0.w); w.z = cvt_pk_bf16(a1.x, a1.y); w.w = cvt_pk_bf16(a1.z, a1.w);
                        *(u32x4*)(Q + (size_t)(pm * 256 + rl) * DM + head * 64 + bj * 32 + 8 * fq) = w; }
                } else if (kind == 1) {
                    bf16_t* base = Kf + ((size_t)((b * 8 + head) * KT + tile0 + 2 * ai + wr)) * 4096;
                    const int kblk = m >> 1, r32 = 16 * (m & 1) + fr;
#pragma unroll
                    for (int bj = 0; bj < 2; ++bj) { const int d0 = 2 * bj + (fq >> 1), hi = fq & 1;
                        u32x4 w; w.x = cvt_pk_bf16(v[bj][0].x, v[bj][0].y); w.y = cvt_pk_bf16(v[bj][0].z, v[bj][0].w); w.z = cvt_pk_bf16(v[bj][1].x, v[bj][1].y); w.w = cvt_pk_bf16(v[bj][1].z, v[bj][1].w);
                        *(u32x4*)(base + ((kblk * 4 + d0) * 64 + hi * 32 + r32) * 8) = w; }
                } else {
                    bf16_t* base = Vf + ((size_t)((b * 8 + head) * KT + tile0 + 2 * ai + wr)) * 4096;
#pragma unroll
                    for (int bj = 0; bj < 2; ++bj) {
                        u32x4 w; w.x = cvt_pk_bf16(v[bj][0].x, v[bj][0].y); w.y = cvt_pk_bf16(v[bj][0].z, v[bj][0].w); w.z = cvt_pk_bf16(v[bj][1].x, v[bj][1].y); w.w = cvt_pk_bf16(v[bj][1].z, v[bj][1].w);
                        *(u32x4*)(base + ((4 * m + (fr >> 2)) * 4 + 2 * bj + (fq >> 1)) * 64 + (fr & 3) * 16 + (fq & 1) * 8) = w; }
                }
                if (m & 1) asm volatile("" ::: "memory");
            }
    }
};

struct EpiRes {
    static constexpr bool PERM = false, AFTER_DRAIN = false;
    float* X; const float* Xin; const float* modl; int goff; bf16_t* PB;
    __device__ __forceinline__ void operator()(const pg8::f32x4 (&acc)[2][2][4][2], const pg8::Unit& u, int wr_, int wc_, int fr_, int fq_) const {
        int wr = wr_, wc = wc_, fr = fr_, fq = fq_; asm volatile("" : "+s"(wr), "+s"(wc), "+v"(fr), "+v"(fq));
        const int bidx = u.pm < 64 ? (u.pm >> 3) : 8;
        const float* gate = modl + (size_t)bidx * NMOD + goff;
        const int c0 = u.pn * 256 + wc * 32 + 4 * fq;
        f32x4 gv[2][2];
#pragma unroll
        for (int bj = 0; bj < 2; ++bj)
#pragma unroll
            for (int n = 0; n < 2; ++n) gv[bj][n] = *(const f32x4*)(gate + c0 + 128 * bj + 16 * n);
        if (u.part) {
            bf16_t* pb = PB + (size_t)(u.part - 1) * MC * DM;
#pragma unroll
            for (int ai = 0; ai < 2; ++ai)
#pragma unroll
                for (int m = 0; m < 4; ++m) { bf16_t* pr = pb + (size_t)((u.pm - 64) * 256 + 128 * ai + 64 * wr + 16 * m + fr) * DM + c0;
#pragma unroll
                    for (int bj = 0; bj < 2; ++bj)
#pragma unroll
                        for (int n = 0; n < 2; ++n) { const f32x4 v = gv[bj][n] * acc[ai][bj][m][n]; u32x2 o; o.x = cvt_pk_bf16(v.x, v.y); o.y = cvt_pk_bf16(v.z, v.w); *(u32x2*)(pr + 128 * bj + 16 * n) = o; } }
            return;
        }
#pragma unroll
        for (int ai = 0; ai < 2; ++ai)
#pragma unroll
            for (int m = 0; m < 4; ++m) { const size_t ro = (size_t)(u.pm * 256 + 128 * ai + 64 * wr + 16 * m + fr) * DM + c0; float* xr = X + ro; const float* xi = Xin + ro;
#pragma unroll
                for (int bj = 0; bj < 2; ++bj)
#pragma unroll
                    for (int n = 0; n < 2; ++n) { *(f32x4*)(xr + 128 * bj + 16 * n) = *(const f32x4*)(xi + 128 * bj + 16 * n) + gv[bj][n] * acc[ai][bj][m][n]; }
                if (m & 1) asm volatile("" ::: "memory"); }

    }
};

struct EpiUp {
    static constexpr bool PERM = true, AFTER_DRAIN = false;
    bf16_t* HID; float* EDGE; const float* cw; const float* cb;
    __device__ __forceinline__ void operator()(const pg8::f32x4 (&acc)[2][2][4][2], const pg8::Unit& u, int wr_, int wc_, int fr_, int fq_) const {
        int wr = wr_, wc = wc_, fr = fr_, fq = fq_; asm volatile("" : "+s"(wr), "+s"(wc), "+v"(fr), "+v"(fq));
        const int col0 = 128 * u.pn + 32 * wc + 8 * fq;
        f32x4 w0[2], w1[2], w2[2], bb[2];
#pragma unroll
        for (int n = 0; n < 2; ++n) { w0[n] = *(const f32x4*)(cw + col0 + 4 * n); w1[n] = *(const f32x4*)(cw + DFF + col0 + 4 * n); w2[n] = *(const f32x4*)(cw + 2 * DFF + col0 + 4 * n); bb[n] = *(const f32x4*)(cb + col0 + 4 * n); }
#pragma unroll
        for (int ai = 0; ai < 2; ++ai) {
            const int g = u.pm * 4 + 2 * ai + wr;
#pragma unroll
            for (int m = 0; m < 4; ++m) {
                const int row = u.pm * 256 + 128 * ai + 64 * wr + 16 * m + fr;
                f32x4 cv[2];
#pragma unroll
                for (int n = 0; n < 2; ++n) {
                    const f32x4 av = acc[ai][0][m][n];
                    f32x4 pv, nv;
#pragma unroll
                    for (int j = 0; j < 4; ++j) {
                        const float p1 = dpp_ror1(av[j]); const float p2 = m > 0 ? dpp_ror1(acc[ai][0][m > 0 ? m - 1 : 0][n][j]) : 0.f;
                        pv[j] = fr == 0 ? p2 : p1;
                        const float n1 = dpp_ror15(av[j]); const float n2 = m < 3 ? dpp_ror15(acc[ai][0][m < 3 ? m + 1 : 3][n][j]) : 0.f;
                        nv[j] = fr == 15 ? n2 : n1; }
                    cv[n] = w1[n] * av + bb[n] + w0[n] * pv + w2[n] * nv;
                }
                const bool first = (m == 0 && fr == 0), lastr = (m == 3 && fr == 15);
                if (first || lastr) {
                    float* e = EDGE + ((size_t)(g * 2 + (lastr ? 1 : 0)) * 3) * DFF + col0;
#pragma unroll
                    for (int n = 0; n < 2; ++n) { *(f32x4*)(e + 4 * n) = acc[ai][0][m][n]; *(f32x4*)(e + DFF + 4 * n) = cv[n]; *(f32x4*)(e + 2 * DFF + 4 * n) = acc[ai][1][m][n]; }
                } else {
                    f32x4 h0, h1;
#pragma unroll
                    for (int j = 0; j < 4; ++j) { h0[j] = silu_f(cv[0][j]) * acc[ai][1][m][0][j]; h1[j] = silu_f(cv[1][j]) * acc[ai][1][m][1][j]; }
                    u32x4 w; w.x = cvt_pk_bf16(h0.x, h0.y); w.y = cvt_pk_bf16(h0.z, h0.w); w.z = cvt_pk_bf16(h1.x, h1.y); w.w = cvt_pk_bf16(h1.z, h1.w);
                    __builtin_nontemporal_store(w, (u32x4*)(HID + (size_t)row * DFF + col0));
                }
            }
        }
    }
};

__device__ __forceinline__ void fixup_phase(const float* EDGE, const float* cw, bf16_t* HID, int ngroups) {
    const int total = ngroups * 2 * (DFF / 4);
    for (int idx = blockIdx.x * 512 + threadIdx.x; idx < total; idx += gridDim.x * 512) {
        const int c4 = idx % (DFF / 4), gw = idx / (DFF / 4), which = gw & 1, g = gw >> 1, col = 4 * c4;
        const int seqg = g < 256 ? 32 : 4;
        const float* e = EDGE + ((size_t)(g * 2 + which) * 3) * DFF + col;
        f32x4 part = *(const f32x4*)(e + DFF); const f32x4 bv = *(const f32x4*)(e + 2 * DFF);
        if (which == 0) { if (g % seqg != 0) part += *(const f32x4*)(cw + col) * *(const f32x4*)(EDGE + ((size_t)((g - 1) * 2 + 1) * 3) * DFF + col); }
        else { if ((g + 1) % seqg != 0) part += *(const f32x4*)(cw + 2 * DFF + col) * *(const f32x4*)(EDGE + ((size_t)((g + 1) * 2) * 3) * DFF + col); }
        u32x2 o; o.x = cvt_pk_bf16(silu_f(part.x) * bv.x, silu_f(part.y) * bv.y); o.y = cvt_pk_bf16(silu_f(part.z) * bv.z, silu_f(part.w) * bv.w);
        *(u32x2*)(HID + (size_t)(64 * g + (which ? 63 : 0)) * DFF + col) = o;
    }
}

__device__ __forceinline__ void fixup_tile(const float* EDGE, const float* cw, bf16_t* HID, int g0) {
    for (int idx = threadIdx.x; idx < 4 * 2 * (DFF / 4); idx += 512) {
        const int c4 = idx % (DFF / 4), gw = idx / (DFF / 4), which = gw & 1, g = g0 + (gw >> 1), col = 4 * c4;
        const int seqg = g < 256 ? 32 : 4;
        const float* e = EDGE + ((size_t)(g * 2 + which) * 3) * DFF + col;
        f32x4 part = *(const f32x4*)(e + DFF); const f32x4 bv = *(const f32x4*)(e + 2 * DFF);
        if (which == 0) { if (g % seqg != 0) part += *(const f32x4*)(cw + col) * *(const f32x4*)(EDGE + ((size_t)((g - 1) * 2 + 1) * 3) * DFF + col); }
        else { if ((g + 1) % seqg != 0) part += *(const f32x4*)(cw + 2 * DFF + col) * *(const f32x4*)(EDGE + ((size_t)((g + 1) * 2) * 3) * DFF + col); }
        u32x2 o; o.x = cvt_pk_bf16(silu_f(part.x) * bv.x, silu_f(part.y) * bv.y); o.y = cvt_pk_bf16(silu_f(part.z) * bv.z, silu_f(part.w) * bv.w);
        *(u32x2*)(HID + (size_t)(64 * g + (which ? 63 : 0)) * DFF + col) = o;
    }
}

struct AttnP { const bf16_t* Q; bf16_t* O; const bf16_t* Kf; const bf16_t* Vf; const float* rpb; const float* sink; unsigned* counter; int nunits; float bbound; unsigned* xq; };

typedef short v4i16_t __attribute__((ext_vector_type(4)));
typedef float f32x2 __attribute__((ext_vector_type(2)));
__device__ __forceinline__ float half_max(float m) { auto rr = __builtin_amdgcn_permlane32_swap(__float_as_uint(m), __float_as_uint(m), false, false); return fmaxf(__uint_as_float(rr[0]), __uint_as_float(rr[1])); }
__device__ __forceinline__ float half_sum(float m) { auto rr = __builtin_amdgcn_permlane32_swap(__float_as_uint(m), __float_as_uint(m), false, false); return __uint_as_float(rr[0]) + __uint_as_float(rr[1]); }
#define MX3(a, b, c) __builtin_fmaxf(__builtin_fmaxf((a), (b)), (c))

__device__ __forceinline__ void glds16(const void* gsrc, unsigned lds_dst) { unsigned keep;
    asm volatile("s_mov_b32 %0, m0\n\ts_mov_b32 m0, %2\n\ts_nop 0\n\tglobal_load_lds_dwordx4 %1, off\n\ts_mov_b32 m0, %0" : "=&s"(keep) : "v"(gsrc), "s"(lds_dst) : "memory"); }
template <int MODE, bool NM = false> __device__ __forceinline__ void attn_unit(LAS unsigned char* lds, const AttnP& P, int b, int qhead, int kvh, int qpos0, int qrow0, int tlo, int thi, int sinkidx) {
    int tid_l = threadIdx.x; asm volatile("" : "+v"(tid_l));
    const int tid = tid_l, lane = tid & 63, wid = __builtin_amdgcn_readfirstlane(tid >> 6), r32 = lane & 31, hi = lane >> 5;
    LAS unsigned char* ldsK = lds; LAS unsigned char* ldsV = lds + 32768;
    LAS float* tab = (LAS float*)(lds + 65536);
    volatile LAS int* qw = (volatile LAS int*)(lds + 65536 + 4096);
    const unsigned ldsK0 = (unsigned)(size_t)ldsK, ldsV0 = (unsigned)(size_t)ldsV;
    const int vlane = hi * 512 + ((lane >> 4) & 1) * 128 + ((lane & 15) >> 2) * 32 + (lane & 3) * 8;
    constexpr float THR = 8.0f;
    {
        const int nsteps = 4 + (thi - tlo);
        const bf16_t* kbase = P.Kf + (size_t)((b * 8 + kvh) * KT) * 4096 + tid * 8;
        const bf16_t* vbase = P.Vf + (size_t)((b * 8 + kvh) * KT) * 4096 + tid * 8;
        bf16x8 qf[4];
        { const bf16_t* qp = P.Q + (size_t)(qrow0 + wid * 32 + r32) * DM + qhead * 64 + hi * 8;
#pragma unroll
          for (int d0 = 0; d0 < 4; ++d0) qf[d0] = *(const bf16x8*)(qp + d0 * 16); }
        if (MODE == 1) { for (int i = tid; i < 15 * 31; i += 512) tab[i] = P.rpb[qhead * 465 + i] * LOG2E; }
        const int qw0 = qpos0 + wid * 32;
        const int qpos = qw0 + r32;
        float mref = 0.f, lrun = 0.f;
        f32x16 o0, o1, negm;
#pragma unroll
        for (int i = 0; i < 16; ++i) { o0[i] = 0.f; o1[i] = 0.f; negm[i] = 0.f; }
#define ATT_TILE(s_) ((s_) < 4 ? 32 + (s_) : tlo + (s_) - 4)
#define ATT_DMA(s_) do { const int tt_ = ATT_TILE(s_); const unsigned sl_ = (unsigned)(((s_) & 3) * 8192 + wid * 1024); \
            glds16(kbase + (size_t)tt_ * 4096, (unsigned)__builtin_amdgcn_readfirstlane(ldsK0 + sl_)); \
            glds16(vbase + (size_t)tt_ * 4096, (unsigned)__builtin_amdgcn_readfirstlane(ldsV0 + sl_)); } while (0)
        ATT_DMA(0); ATT_DMA(1); ATT_DMA(2);
        asm volatile("s_waitcnt vmcnt(0)" : "+v"(qf[0]), "+v"(qf[1]), "+v"(qf[2]), "+v"(qf[3]) :: "memory");
        for (int st = 0; st < nsteps; ++st) {
            const int rem = nsteps - 1 - st;
            if (rem >= 2) asm volatile("s_waitcnt vmcnt(4)" ::: "memory"); else if (rem == 1) asm volatile("s_waitcnt vmcnt(2)" ::: "memory"); else asm volatile("s_waitcnt vmcnt(0)" ::: "memory");
            asm volatile("s_waitcnt lgkmcnt(0)" ::: "memory");
            __builtin_amdgcn_s_barrier();
            asm volatile("" ::: "memory");
            const int t = ATT_TILE(st);
            if (st + 3 < nsteps) ATT_DMA(st + 3);
            const int buf = st & 3;
            bool skip = false;
            if (st >= 4) {
                if (MODE == 1) { const int qr = qw0 >> 6, rs = min(max(qr - 4, 0), 24); skip = (t < rs) || (t >= rs + 8); }
                else if (MODE == 2) { skip = (64 * t > qw0 + 31 + 128) || (64 * t + 63 < qw0 - 128); }
            }
            if (!skip) {
            const LAS unsigned char* kb = ldsK + buf * 8192 + lane * 16;
            const LAS unsigned char* vb = ldsV + buf * 8192 + vlane;
            f32x16 s0, s1;
            {
                bf16x8 kf[8];
#pragma unroll
                for (int i = 0; i < 8; ++i) kf[i] = *(const LAS bf16x8*)(kb + i * 1024);
                __builtin_amdgcn_sched_barrier(0);
                if (NM) { const f32x16 z = {0.f, 0.f, 0.f, 0.f, 0.f, 0.f, 0.f, 0.f, 0.f, 0.f, 0.f, 0.f, 0.f, 0.f, 0.f, 0.f};
                    s0 = __builtin_amdgcn_mfma_f32_32x32x16_bf16(kf[0], qf[0], z, 0, 0, 0); s1 = __builtin_amdgcn_mfma_f32_32x32x16_bf16(kf[4], qf[0], z, 0, 0, 0); }
                else { s0 = __builtin_amdgcn_mfma_f32_32x32x16_bf16(kf[0], qf[0], negm, 0, 0, 0); s1 = __builtin_amdgcn_mfma_f32_32x32x16_bf16(kf[4], qf[0], negm, 0, 0, 0); }
#pragma unroll
                for (int d0 = 1; d0 < 4; ++d0) { s0 = __builtin_amdgcn_mfma_f32_32x32x16_bf16(kf[d0], qf[d0], s0, 0, 0, 0); s1 = __builtin_amdgcn_mfma_f32_32x32x16_bf16(kf[4 + d0], qf[d0], s1, 0, 0, 0); }
                __builtin_amdgcn_sched_barrier(0);
            }
            v4i16_t vlo[8], vhi[8];
#pragma unroll
            for (int i = 0; i < 8; ++i) { vlo[i] = __builtin_amdgcn_ds_read_tr16_b64_v4i16((LAS v4i16_t*)(vb + (i & 3) * 2048 + (i >> 2) * 256));
                                          vhi[i] = __builtin_amdgcn_ds_read_tr16_b64_v4i16((LAS v4i16_t*)(vb + (i & 3) * 2048 + (i >> 2) * 256 + 1024)); }
            __builtin_amdgcn_sched_barrier(0);
            if (st >= 4) {
                if (MODE == 2 && !((64 * t >= qw0 + 31 - 128) && (64 * t + 63 <= qw0 + 128))) {
                    const int base = qpos - 64 * t - 4 * hi;
#pragma unroll
                    for (int i = 0; i < 16; ++i) { const int d = base - ((i & 3) + 8 * (i >> 2));
                        if (d > 128 || d < -128) s0[i] = NEGBIG;
                        if (d - 32 > 128 || d - 32 < -128) s1[i] = NEGBIG;
                        if ((i & 3) == 3) asm volatile("" : "+v"(s0), "+v"(s1)); }
                } else if (MODE == 1) {
                    const int qr = qpos >> 6, qc = qpos & 63;
                    const int cs = min(max(qc - 8, 0), 48);
                    const int tb = (t - qr + 7) * 31 + 15 - qc;
#pragma unroll
                    for (int i = 0; i < 16; ++i) { const int kk = 4 * hi + (i & 3) + 8 * (i >> 2);
                        const bool ok0 = kk >= cs && kk < cs + 16;
                        const bool ok1 = kk + 32 >= cs && kk + 32 < cs + 16;
                        int i0_ = ok0 ? tb + kk : 0, i1_ = ok1 ? tb + kk + 32 : 0; asm volatile("" : "+v"(i0_), "+v"(i1_));
                        const float b0 = tab[i0_], b1 = tab[i1_];
                        s0[i] = ok0 ? s0[i] + b0 : NEGBIG; s1[i] = ok1 ? s1[i] + b1 : NEGBIG;
                        if ((i & 3) == 3) asm volatile("" ::: "memory"); }
                }
            }
            if (!NM) {
            float ma = MX3(s0[0], s0[1], s1[0]), mb = MX3(s0[2], s0[3], s1[1]); ma = MX3(ma, s1[2], s1[3]);
#pragma unroll
            for (int r = 4; r < 16; r += 4) { ma = MX3(ma, s0[r], s0[r + 1]); mb = MX3(mb, s0[r + 2], s0[r + 3]); ma = MX3(ma, s1[r], s1[r + 1]); mb = MX3(mb, s1[r + 2], s1[r + 3]); }
            const float mx = half_max(fmaxf(ma, mb));
            if (st == 0) {
                mref = mx;
#pragma unroll
                for (int i = 0; i < 16; ++i) { s0[i] -= mx; s1[i] -= mx; negm[i] = -mx; }
            } else if (__any(mx > THR)) {
                const float dl = fmaxf(mx, 0.f); mref += dl;
                const float f = __builtin_amdgcn_exp2f(-dl); lrun *= f;
#pragma unroll
                for (int i = 0; i < 16; ++i) { s0[i] -= dl; s1[i] -= dl; negm[i] = -mref; o0[i] *= f; o1[i] *= f; }
            }
            }
            float lsa = 0.f, lsb = 0.f;
#pragma unroll
            for (int i = 0; i < 16; i += 2) { s0[i] = __builtin_amdgcn_exp2f(s0[i]); s0[i + 1] = __builtin_amdgcn_exp2f(s0[i + 1]); s1[i] = __builtin_amdgcn_exp2f(s1[i]); s1[i + 1] = __builtin_amdgcn_exp2f(s1[i + 1]);
                lsa += s0[i]; lsb += s0[i + 1]; asm volatile("" : "+v"(lsa), "+v"(lsb)); lsa += s1[i]; lsb += s1[i + 1]; asm volatile("" : "+v"(lsa), "+v"(lsb)); }
            lrun += lsa + lsb;
            u32x4 pw[4];
#pragma unroll
            for (int c = 0; c < 2; ++c) {
                pw[c].x = cvt_pk_bf16(s0[8 * c + 0], s0[8 * c + 1]); pw[c].y = cvt_pk_bf16(s0[8 * c + 2], s0[8 * c + 3]); pw[c].z = cvt_pk_bf16(s0[8 * c + 4], s0[8 * c + 5]); pw[c].w = cvt_pk_bf16(s0[8 * c + 6], s0[8 * c + 7]);
                pw[2 + c].x = cvt_pk_bf16(s1[8 * c + 0], s1[8 * c + 1]); pw[2 + c].y = cvt_pk_bf16(s1[8 * c + 2], s1[8 * c + 3]); pw[2 + c].z = cvt_pk_bf16(s1[8 * c + 4], s1[8 * c + 5]); pw[2 + c].w = cvt_pk_bf16(s1[8 * c + 6], s1[8 * c + 7]); }
            __builtin_amdgcn_sched_barrier(0);
#pragma unroll
            for (int c = 0; c < 4; ++c) {
                const bf16x8 v0 = (bf16x8){vlo[c][0], vlo[c][1], vlo[c][2], vlo[c][3], vhi[c][0], vhi[c][1], vhi[c][2], vhi[c][3]};
                const bf16x8 v1 = (bf16x8){vlo[4 + c][0], vlo[4 + c][1], vlo[4 + c][2], vlo[4 + c][3], vhi[4 + c][0], vhi[4 + c][1], vhi[4 + c][2], vhi[4 + c][3]};
                const bf16x8 pf = __builtin_bit_cast(bf16x8, pw[c]);
                o0 = __builtin_amdgcn_mfma_f32_32x32x16_bf16(v0, pf, o0, 0, 0, 0);
                o1 = __builtin_amdgcn_mfma_f32_32x32x16_bf16(v1, pf, o1, 0, 0, 0); }
            }
        }
        lrun = half_sum(lrun);
        if (sinkidx >= 0) lrun += __builtin_amdgcn_exp2f(P.sink[sinkidx] * LOG2E - mref);
        const float inv = 1.0f / lrun;
        bf16_t* op = P.O + (size_t)(qrow0 + wid * 32 + r32) * DM + qhead * 64 + 4 * hi;
#pragma unroll
        for (int g = 0; g < 4; ++g) {
            u32x2 w; w.x = cvt_pk_bf16(o0[4 * g] * inv, o0[4 * g + 1] * inv); w.y = cvt_pk_bf16(o0[4 * g + 2] * inv, o0[4 * g + 3] * inv);
            *(u32x2*)(op + 8 * g) = w;
            u32x2 w2; w2.x = cvt_pk_bf16(o1[4 * g] * inv, o1[4 * g + 1] * inv); w2.y = cvt_pk_bf16(o1[4 * g + 2] * inv, o1[4 * g + 3] * inv);
            *(u32x2*)(op + 32 + 8 * g) = w2; }
        __syncthreads();
    }
}

__device__ __forceinline__ void attn_phase(LAS unsigned char* lds, const AttnP P) {
    volatile LAS int* qw = (volatile LAS int*)(lds + 65536 + 4096);
    const bool xcdq = (gridDim.x == 256);
    const unsigned myx = xb_xcc_id() & 7u;
    bool bdone = !xcdq;
#define ATT_FETCH(dst_) do { int r_ = -1; \
        if (!bdone) { const unsigned j_ = atomicAdd(P.xq + 8 * myx, 1u); \
            if (j_ < 64u) { const unsigned gi_ = myx + 8u * (j_ >> 5), r2_ = j_ & 31u; r_ = (int)((gi_ >> 1) * 64u + ((gi_ & 1u) * 4u + (r2_ >> 3)) * 8u + (r2_ & 7u)); } else bdone = true; } \
        if (r_ < 0) r_ = (xcdq ? 512 : 0) + (int)atomicAdd(P.counter, 1u); \
        dst_ = r_; } while (0)
    int nxt = 0;
    if (threadIdx.x == 0) ATT_FETCH(nxt);
    for (;;) {
        if (threadIdx.x == 0) qw[0] = nxt;
        __syncthreads();
        const int u = qw[0];
        if (u >= P.nunits) break;
        if (threadIdx.x == 0) ATT_FETCH(nxt);
        int mode, b, qhead, kvh, qpos0 = 0, qrow0, tlo = 0, thi = 0, sinkidx = -1;
        if (u < 512) { mode = 0; b = u >> 6; const int g = (u >> 3) & 7, qb = u & 7; qhead = 4 + g; kvh = 4 + (g >> 2); qpos0 = qb * 256; qrow0 = b * SEQ + qpos0; tlo = 0; thi = 32; }
        else if (u < 768) { const int v = u - 512; mode = 1; b = v >> 5; const int h = (v >> 3) & 3, qb = v & 7; qhead = h; kvh = h; qpos0 = qb * 256; qrow0 = b * SEQ + qpos0;
            const int r0 = 4 * qb; tlo = min(max(r0 - 4, 0), 24); thi = min(max(r0 - 1, 0), 24) + 8; }
        else if (u < 1024) { const int v = u - 768; mode = 2; b = v >> 5; const int h = (v >> 3) & 3, qb = v & 7; qhead = 12 + h; kvh = 6 + (h >> 1); qpos0 = qb * 256; qrow0 = b * SEQ + qpos0;
            tlo = max(0, 4 * qb - 2); thi = min(32, 4 * qb + 6); sinkidx = h; }
        else { const int v = u - 1024; mode = 3; b = v >> 4; qhead = v & 15; kvh = qhead < 4 ? qhead : (qhead < 12 ? 4 + ((qhead - 4) >> 2) : 6 + ((qhead - 12) >> 1)); qrow0 = ML + b * CTXL;
            if (qhead >= 12) sinkidx = qhead - 12; }
        if (mode == 1) attn_unit<1>(lds, P, b, qhead, kvh, qpos0, qrow0, tlo, thi, sinkidx);
        else if (mode == 2) attn_unit<2>(lds, P, b, qhead, kvh, qpos0, qrow0, tlo, thi, sinkidx);
        else if (P.bbound < 64.0f && qhead >= 4 && qhead < 12) attn_unit<0, true>(lds, P, b, qhead, kvh, qpos0, qrow0, tlo, thi, sinkidx);
        else attn_unit<0>(lds, P, b, qhead, kvh, qpos0, qrow0, tlo, thi, sinkidx);
    }
}

__global__ void __launch_bounds__(512, 2) mega_fwd(Args a) {
    extern __shared__ __attribute__((aligned(16))) unsigned char lds_raw[];
    LAS unsigned char* lds = (LAS unsigned char*)lds_raw;
    cg::grid_group grid = cg::this_grid();
    volatile LAS unsigned* bst = (volatile LAS unsigned*)(lds + 131072 + 64);
    if (threadIdx.x == 0) { bst[0] = 0u; bst[1] = 0u; }
    __syncthreads();
    const XcdBarrier xbar = xcd_barrier_post((unsigned*)(a.ws + WS_CTL) + 4096, bst);
    volatile LAS unsigned* vcw = (volatile LAS unsigned*)(lds + 131072 + 160);
    if (threadIdx.x == 0) { const unsigned x_ = xb_xcc_id() & 7u; vcw[0] = atomicAdd((unsigned*)(a.ws + WS_CTL) + 3072 + 8 * x_, 1u) * 8u + x_; }
    __syncthreads();
#ifndef PH
#define PH 0xFFF
#endif
#ifndef PROBE
#define PROBE 0
#endif
#define PHASE_BEGIN() unsigned char* ws = a.ws; int G = gridDim.x, bx = vcu_ok ? (int)vcw[0] : (int)blockIdx.x; bx = __builtin_amdgcn_readfirstlane(bx); asm volatile("" : "+s"(ws), "+s"(G), "+s"(bx))
    if (PH & 1) prologue(a, lds);
    if (PROBE == 5) { __syncthreads(); prologue(a, lds); }
    if (a.ws == nullptr) grid.sync();
    xcd_barrier(xbar);
    bool vcu_ok = (gridDim.x % 8u) == 0u;
    { const unsigned* cen = (const unsigned*)(a.ws + WS_CTL) + 3072;
#pragma unroll
      for (int j = 0; j < 8; ++j) vcu_ok = vcu_ok && (__hip_atomic_load(cen + 8 * j, __ATOMIC_RELAXED, __HIP_MEMORY_SCOPE_AGENT) == gridDim.x / 8u); }

    for (int l = 0; l < DEPTH; ++l) {
        const bool last = (l == DEPTH - 1);
        const int Mff = last ? ML : MT;
        if (PH & 2) { PHASE_BEGIN(); (void)G; (void)bx;
            const float* modl = (const float*)(ws + WS_MOD) + (size_t)l * 9 * NMOD; float* X = (float*)(ws + WS_X); bf16_t* H = (bf16_t*)(ws + WS_H);
            const float* cp = (const float*)(ws + WS_CP);
            if (l == 0) norm_phase(a.in[0], a.in[2], X, cp + CP_AN, modl, 0, 1024, H, MT);
            else        norm_phase(X, X + (size_t)ML * DM, nullptr, cp + CP_AN + l * DM, modl, 0, 1024, H, MT, gridDim.x == 256 ? (const bf16_t*)(ws + WS_PB) : (const bf16_t*)nullptr); }
        xcd_barrier(xbar); if (PROBE == 4) xcd_barrier(xbar);
        if (PH & 4) { PHASE_BEGIN();
          pg8::Gemm g{(bf16_t*)(ws + WS_H), (bf16_t*)(ws + WS_WIN) + (size_t)l * DPROJ * DM, MT, DPROJ, DM}; pg8::StaticOrder S; S.init(MT, DPROJ, G, bx);
          const float* cosT = (const float*)(ws + WS_ROPE);
          EpiQKV E{(bf16_t*)(ws + WS_Q), (bf16_t*)(ws + WS_K), (bf16_t*)(ws + WS_V), (const float*)(ws + WS_GAIN) + l * 128, cosT, cosT + SEQ * 32};
          pg8::gemm_phase<EpiQKV, pg8::StaticOrder, true, true>(lds, g, S, E);
          if (PROBE == 2) { xcd_barrier(xbar); pg8::gemm_phase<EpiQKV, pg8::StaticOrder, true, true>(lds, g, S, E); } }
        xcd_barrier(xbar); if (PROBE == 4) xcd_barrier(xbar);
        if (PH & 8) { PHASE_BEGIN(); (void)G; (void)bx;
          const float* cp = (const float*)(ws + WS_CP);
          AttnP P{(bf16_t*)(ws + WS_Q), (bf16_t*)(ws + WS_O), (bf16_t*)(ws + WS_K), (bf16_t*)(ws + WS_V), cp + CP_RPB + l * 4 * 465, cp + CP_SINK + l * 4, (unsigned*)(ws + WS_CTL) + 64 * l, last ? 1024 : 1152, *((const float*)(ws + WS_GAIN) + 512 + l), (unsigned*)(ws + WS_CTL) + 2048 + 64 * l};
          attn_phase(lds, P);
          if (PROBE == 1) { xcd_barrier(xbar); AttnP P2 = P; P2.counter = (unsigned*)(ws + WS_CTL) + 64 * (l + 4); attn_phase(lds, P2); } }
        xcd_barrier(xbar); if (PROBE == 4) xcd_barrier(xbar);
        if (PH & 16) { PHASE_BEGIN();
          pg8::Gemm g{(bf16_t*)(ws + WS_O), (bf16_t*)(ws + WS_WOUT) + (size_t)l * DM * DM, Mff, DM, DM}; pg8::SplitCtxOrder S; S.init(Mff, DM, G, bx);
          EpiRes E{(float*)(ws + WS_X), (l == 0 && G == 256) ? a.in[0] : (const float*)(ws + WS_X), (const float*)(ws + WS_MOD) + (size_t)l * 9 * NMOD, 2048, (bf16_t*)(ws + WS_PB)};
          pg8::gemm_phase<EpiRes, pg8::SplitCtxOrder, true, true>(lds, g, S, E); }
        xcd_barrier(xbar); if (PROBE == 4) xcd_barrier(xbar);
        if (PH & 32) { PHASE_BEGIN(); (void)G; (void)bx;
            const float* modl = (const float*)(ws + WS_MOD) + (size_t)l * 9 * NMOD; float* X = (float*)(ws + WS_X);
            const float* cp = (const float*)(ws + WS_CP);
            norm_phase(X, X + (size_t)ML * DM, nullptr, cp + CP_FN + l * DM, modl, 3072, 4096, (bf16_t*)(ws + WS_H), Mff, (last || gridDim.x != 256) ? (const bf16_t*)nullptr : (const bf16_t*)(ws + WS_PB)); }
        xcd_barrier(xbar); if (PROBE == 4) xcd_barrier(xbar);
        if (PH & 64) { PHASE_BEGIN();
          pg8::Gemm g{(bf16_t*)(ws + WS_H), (bf16_t*)(ws + WS_WUP) + (size_t)l * 2 * DFF * DM, Mff, 2 * DFF, DM}; pg8::StaticOrder S; S.init(Mff, 2 * DFF, G, bx);
          const float* cp = (const float*)(ws + WS_CP) + CP_CONV;
          EpiUp E{(bf16_t*)(ws + WS_HID), (float*)(ws + WS_EDGE), cp + (size_t)l * 4 * DFF, cp + (size_t)l * 4 * DFF + 3 * DFF};
          pg8::gemm_phase<EpiUp, pg8::StaticOrder, true, true>(lds, g, S, E);
          if (PROBE == 3) { xcd_barrier(xbar); pg8::gemm_phase<EpiUp, pg8::StaticOrder, true, true>(lds, g, S, E); } }
        xcd_barrier(xbar); if (PROBE == 4) xcd_barrier(xbar);
        if (PH & 256) { PHASE_BEGIN();
          pg8::Gemm g{(bf16_t*)(ws + WS_HID), (bf16_t*)(ws + WS_WDN) + (size_t)l * DM * DFF, Mff, DM, DFF}; pg8::SplitCtxOrder S; S.init(Mff, DFF, G, bx);
          EpiRes E{(float*)(ws + WS_X), (const float*)(ws + WS_X), (const float*)(ws + WS_MOD) + (size_t)l * 9 * NMOD, 5120, (bf16_t*)(ws + WS_PB)};
          { const float* cpc = (const float*)(ws + WS_CP) + CP_CONV + (size_t)l * 4 * DFF; pg8::Unit fu;
            for (int i = 0; S.next(i, fu); ++i) fixup_tile((const float*)(ws + WS_EDGE), cpc, (bf16_t*)(ws + WS_HID), 4 * fu.pm);
            __syncthreads(); }
          pg8::gemm_phase<EpiRes, pg8::SplitCtxOrder, true, true>(lds, g, S, E); }
        xcd_barrier(xbar); if (PROBE == 4) xcd_barrier(xbar);
    }
    if (PH & 512) { PHASE_BEGIN(); (void)G; (void)bx; final_norm_phase((const float*)(ws + WS_X), (const float*)(ws + WS_CP) + CP_FIN, a.out); }
}

extern "C" void kernel_launch(void* const* d_in, const int* in_sizes, int n_in, void* d_out, int out_size, void* d_ws, size_t ws_size, hipStream_t stream) {
    static int grid = 0;
    if (grid == 0) {
        if (n_in != 19 || ws_size < WS_END) { fprintf(stderr, "kernel_launch: unexpected n_in %d or ws_size %zu (< %zu)\n", n_in, ws_size, (size_t)WS_END); grid = -1; return; }
        int dev = 0, cus = 0, per_cu = 0;
        (void)hipGetDevice(&dev);
        (void)hipDeviceGetAttribute(&cus, hipDeviceAttributeMultiprocessorCount, dev);
        if (hipFuncSetAttribute((const void*)mega_fwd, hipFuncAttributeMaxDynamicSharedMemorySize, LDS_BYTES) != hipSuccess) fprintf(stderr, "kernel_launch: hipFuncSetAttribute failed\n");
        if (hipOccupancyMaxActiveBlocksPerMultiprocessor(&per_cu, (const void*)mega_fwd, 512, LDS_BYTES) != hipSuccess || per_cu < 1) { fprintf(stderr, "kernel_launch: occupancy query says %d\n", per_cu); per_cu = 1; }
        (void)hipGetLastError();
        grid = cus * per_cu;
        fprintf(stderr, "kernel_launch: grid %d (cus %d x %d)\n", grid, cus, per_cu);
    }
    if (grid < 0) return;
    (void)hipMemsetAsync(d_ws, 0, 65536, stream);
    Args a{};
    for (int i = 0; i < 19; ++i) a.in[i] = (const float*)d_in[i];
    a.out = (float*)d_out; a.ws = (unsigned char*)d_ws;
    void* args[] = {&a};
    hipError_t e = hipLaunchCooperativeKernel((const void*)mega_fwd, dim3(grid), dim3(512), args, LDS_BYTES, stream);
    if (e != hipSuccess) fprintf(stderr, "kernel_launch: cooperative launch failed: %s (grid %d)\n", hipGetErrorString(e), grid);
}
```

```cpp
#include <hip/hip_runtime.h>
#include <hip/hip_cooperative_groups.h>
#include <cstdio>
#include <cstdint>
namespace cg = cooperative_groups;
namespace pg8 {
#define PG8_LAS __attribute__((address_space(3)))
typedef unsigned short bf16_t;
typedef short bf16x8 __attribute__((ext_vector_type(8)));
typedef float f32x4 __attribute__((ext_vector_type(4)));
typedef unsigned u32x4 __attribute__((ext_vector_type(4)));
constexpr int BM = 256, BK = 64, HALF = 128, HTB = HALF * BK * 2  , STAGE_BYTES = 8 * HTB, NXCD = 8, WGM = 8;

__host__ __device__ __forceinline__ int lds_byte(int r, int c) { const int st = (r >> 4) * 2 + (c >> 5), rr = r & 15, cc = c & 31, ob = rr * 64 + cc * 2; return st * 1024 + (ob ^ (((ob >> 9) & 1) << 5)); }
__host__ __device__ __forceinline__ void stage_rc(int b, int& R, int& C) { const int st = b / 1024, sb = b % 1024, swz = sb ^ (((sb >> 9) & 1) << 5); R = (st >> 1) * 16 + swz / 64; C = (st & 1) * 32 + (swz % 64) / 2; }
__host__ __device__ __forceinline__ int perm32(int rho) { const int n = rho >> 4, i = rho & 15; return 8 * (i >> 2) + 4 * n + (i & 3); }

struct Unit { int pm, pn, kt0, nt, part; };
struct Gemm { const bf16_t* A; const bf16_t* Bt; int M, N, K; };

struct StaticOrder {
    int nM, nN, nwg, G, c, ntf;
    __host__ __device__ void init(int M, int N, int G_, int c_, int K_ = 1024) { nM = M / BM; nN = N / BM; nwg = nM * nN; G = G_; c = c_; ntf = K_ / BK; }
    __host__ __device__ bool next(int i, Unit& u) const {
        const long L = (long)i * G + c; if (L >= nwg) return false;
        int wgid = (int)L; { const int q = nwg / NXCD, r = nwg % NXCD, xcd = wgid % NXCD, off = wgid / NXCD; wgid = (xcd < r ? xcd * (q + 1) : r * (q + 1) + (xcd - r) * q) + off; }
        const int wgm = (nM % NXCD == 0) ? nM / NXCD : WGM;
        const int nig = wgm * nN, gid = wgid / nig, fm = gid * wgm, gsz = (nM - fm) < wgm ? (nM - fm) : wgm;
        u.pm = fm + ((wgid % nig) % gsz); u.pn = (wgid % nig) / gsz; u.kt0 = 0; u.nt = ntf; u.part = 0; return true;
    }
    __device__ __forceinline__ void a_ready(const Unit&) const {}
    __device__ __forceinline__ void done(const Unit&) const {}
};


struct SplitCtxOrder {
    StaticOrder lat, all; bool split; int c, ntf;
    __host__ __device__ void init(int M, int K, int G, int c_) { c = c_; ntf = K / BK; split = (G == 256) && (M > 16384); lat.init(16384, 1024, G, c_, K); all.init(M, 1024, G, c_, K); }
    __host__ __device__ bool next(int i, Unit& u) const {
        Unit a; a.pm = 0; a.pn = 0; a.kt0 = 0; a.nt = ntf; a.part = 0; bool ok;
        if (!split) { Unit t; t.pm = 0; t.pn = 0; t.kt0 = 0; t.nt = ntf; t.part = 0; ok = all.next(i, t); a = t; }
        else if (i == 0) { Unit t; t.pm = 0; t.pn = 0; t.kt0 = 0; t.nt = ntf; t.part = 0; ok = lat.next(0, t); a = t; }
        else { ok = (i == 1) && (c < 128); const int cu = c >> 2, sl = c & 3;
            a.pm = 64 + (cu >> 2); a.pn = cu & 3; a.part = 1 + sl;
            a.kt0 = ntf == 16 ? 4 * sl : (sl == 0 ? 0 : sl == 1 ? 12 : sl == 2 ? 24 : 34); a.nt = ntf == 16 ? 4 : (sl < 2 ? 12 : 10); }
        u.pm = a.pm; u.pn = a.pn; u.kt0 = a.kt0; u.nt = a.nt; u.part = a.part; return ok;
    }
    __device__ __forceinline__ void a_ready(const Unit&) const {}
    __device__ __forceinline__ void done(const Unit&) const {}
};
__device__ __forceinline__ unsigned cvt_pk_bf16(float lo, float hi) { unsigned r; asm volatile("v_cvt_pk_bf16_f32 %0, %1, %2" : "=v"(r) : "v"(lo), "v"(hi)); return r; }
template <class Epi, class Sched, bool ALIGN_EPI = false, bool SP2 = false>
__device__ __forceinline__ void gemm_phase(PG8_LAS unsigned char* lds, const Gemm g, const Sched& S, const Epi& E) {
    int tid_l = threadIdx.x; asm volatile("" : "+v"(tid_l));
    const int tid = tid_l, wid = __builtin_amdgcn_readfirstlane(tid >> 6), lane = tid & 63, wr = wid >> 2, wc = wid & 3, fr = lane & 15, fq = lane >> 4;
    const int K = g.K;
    unsigned voffA[2], voffB[2];
#pragma unroll
    for (int i = 0; i < 2; ++i) { int R, C; stage_rc(tid * 16 + i * 8192, R, C); const int Rb = Epi::PERM ? ((R & ~31) + perm32(R & 31)) : R;
        voffA[i] = (unsigned)(R * K + C) * 2u; voffB[i] = (unsigned)(Rb * K + C) * 2u; }
    const size_t kstep = (size_t)(BK * 2);
    const size_t hstep = (size_t)HALF * K * 2;
    const size_t tstep = 2 * hstep;
    const unsigned ldsw = (unsigned)wid * 1024u;
    const int aoff = lds_byte(wr * 64 + fr, fq * 8), boff = lds_byte(wc * 32 + fr, fq * 8);
#define PG8_SA(b, h) (((b) * 2 + (h)) * HTB)
#define PG8_SB(b, h) ((4 + (b) * 2 + (h)) * HTB)
#define PG8_STAGE(bufoff, gbase, voff) do { _Pragma("unroll") for (int _i = 0; _i < 2; ++_i) \
        __builtin_amdgcn_global_load_lds((const unsigned*)((const char*)(gbase) + (voff)[_i]), (PG8_LAS unsigned*)(lds + (bufoff) + ldsw + _i * 8192), 16, 0, 0); } while (0)
#define PG8_LDA(dst, b, h) do { _Pragma("unroll") for (int m = 0; m < 4; ++m) _Pragma("unroll") for (int k = 0; k < 2; ++k) dst[m][k] = *(const PG8_LAS bf16x8*)(lds + PG8_SA(b, h) + aoff + m * 2048 + k * 1024); } while (0)
#define PG8_LDB(dst, b, h) do { _Pragma("unroll") for (int n = 0; n < 2; ++n) _Pragma("unroll") for (int k = 0; k < 2; ++k) dst[n][k] = *(const PG8_LAS bf16x8*)(lds + PG8_SB(b, h) + boff + n * 2048 + k * 1024); } while (0)
#define PG8_MMA(ai, bj, At, Bt) do { __builtin_amdgcn_s_setprio(1); _Pragma("unroll") for (int m = 0; m < 4; ++m) _Pragma("unroll") for (int n = 0; n < 2; ++n) _Pragma("unroll") for (int k = 0; k < 2; ++k) \
        acc[ai][bj][m][n] = __builtin_amdgcn_mfma_f32_16x16x32_bf16(Bt[n][k], At[m][k], acc[ai][bj][m][n], 0, 0, 0); __builtin_amdgcn_s_setprio(0); } while (0)
#define PG8_WAIT_V(n) asm volatile("s_waitcnt vmcnt(" #n ")" ::: "memory")
#define PG8_WAIT_L(n) asm volatile("s_waitcnt lgkmcnt(" #n ")" ::: "memory")
#define PG8_BAR __builtin_amdgcn_s_barrier()
#define PG8_SCHED __builtin_amdgcn_sched_barrier(0)
    Unit cur, nxt; int ui = 0;
    if (!S.next(0, cur)) return;
    int nt = cur.nt;
    f32x4 acc[2][2][4][2];
#pragma unroll
    for (int a = 0; a < 2; ++a)
#pragma unroll
        for (int b = 0; b < 2; ++b)
#pragma unroll
            for (int m = 0; m < 4; ++m)
#pragma unroll
                for (int n = 0; n < 2; ++n) acc[a][b][m][n] = (f32x4){0.f, 0.f, 0.f, 0.f};
    bf16x8 At[4][2], B0[2][2], B1[2][2];
    const char* cA = (const char*)g.A + (size_t)cur.pm * tstep + (size_t)cur.kt0 * kstep; const char* cB = (const char*)g.Bt + (size_t)cur.pn * tstep + (size_t)cur.kt0 * kstep;
    S.a_ready(cur);
    if constexpr (SP2) {
        PG8_STAGE(PG8_SB(0, 0), cB, voffB); PG8_STAGE(PG8_SB(0, 1), cB + hstep, voffB); PG8_STAGE(PG8_SA(0, 0), cA, voffA); PG8_STAGE(PG8_SA(0, 1), cA + hstep, voffA);
        if (wr == 1) PG8_BAR;
        PG8_WAIT_V(2); PG8_BAR;
        PG8_STAGE(PG8_SB(1, 0), cB + kstep, voffB); PG8_STAGE(PG8_SA(1, 0), cA + kstep, voffA); PG8_STAGE(PG8_SB(1, 1), cB + hstep + kstep, voffB);
        PG8_WAIT_V(6); PG8_BAR;
    } else {
        PG8_STAGE(PG8_SB(0, 0), cB, voffB); PG8_STAGE(PG8_SA(0, 0), cA, voffA); PG8_STAGE(PG8_SB(0, 1), cB + hstep, voffB); PG8_STAGE(PG8_SA(0, 1), cA + hstep, voffA);
        if (wr == 1) PG8_BAR;
        PG8_WAIT_V(4); PG8_BAR;
        PG8_STAGE(PG8_SB(1, 0), cB + kstep, voffB); PG8_STAGE(PG8_SA(1, 0), cA + kstep, voffA); PG8_STAGE(PG8_SB(1, 1), cB + hstep + kstep, voffB);
        PG8_WAIT_V(6); PG8_BAR;
    }
    for (;;) {
        const bool has_next = S.next(ui + 1, nxt);
        const char* nA = has_next ? (const char*)g.A + (size_t)nxt.pm * tstep + (size_t)nxt.kt0 * kstep : cA; const char* nB = has_next ? (const char*)g.Bt + (size_t)nxt.pn * tstep + (size_t)nxt.kt0 * kstep : cB;
        for (int t = 0; t < nt; t += 2) {
            const bool last = (t == nt - 2);
            const char* a1 = cA + (size_t)(t + 1) * kstep;
            const char* a2 = last ? nA : cA + (size_t)(t + 2) * kstep; const char* b2 = last ? nB : cB + (size_t)(t + 2) * kstep;
            const char* a3 = a2 + kstep; const char* b3 = b2 + kstep;
            if (last && has_next) S.a_ready(nxt);
            if constexpr (SP2) {
            PG8_LDB(B0, 0, 0); PG8_LDB(B1, 0, 1); PG8_SCHED; PG8_LDA(At, 0, 0); PG8_STAGE(PG8_SA(1, 1), a1 + hstep, voffA);
            PG8_WAIT_V(8); PG8_WAIT_L(0); PG8_BAR; PG8_MMA(0, 0, At, B0); PG8_MMA(0, 1, At, B1); PG8_BAR; PG8_SCHED;
            PG8_LDA(At, 0, 1); PG8_STAGE(PG8_SB(0, 0), b2, voffB); PG8_STAGE(PG8_SB(0, 1), b2 + hstep, voffB); PG8_STAGE(PG8_SA(0, 0), a2, voffA);
            PG8_WAIT_V(8); PG8_WAIT_L(0); PG8_BAR; PG8_MMA(1, 0, At, B0); PG8_MMA(1, 1, At, B1); PG8_BAR; PG8_SCHED;
            PG8_LDB(B0, 1, 0); PG8_LDB(B1, 1, 1); PG8_SCHED; PG8_LDA(At, 1, 0); PG8_STAGE(PG8_SA(0, 1), a2 + hstep, voffA);
            PG8_WAIT_V(8); PG8_WAIT_L(0); PG8_BAR; PG8_MMA(0, 0, At, B0); PG8_MMA(0, 1, At, B1); PG8_BAR; PG8_SCHED;
            PG8_LDA(At, 1, 1); PG8_STAGE(PG8_SB(1, 0), b3, voffB); PG8_STAGE(PG8_SB(1, 1), b3 + hstep, voffB); PG8_STAGE(PG8_SA(1, 0), a3, voffA);
            PG8_WAIT_V(8); PG8_WAIT_L(0); PG8_BAR; PG8_MMA(1, 0, At, B0); PG8_MMA(1, 1, At, B1); PG8_BAR; PG8_SCHED;
            } else {
            PG8_LDB(B0, 0, 0); PG8_SCHED; PG8_LDA(At, 0, 0); PG8_STAGE(PG8_SA(1, 1), a1 + hstep, voffA);
            PG8_WAIT_L(8); PG8_BAR; PG8_WAIT_L(0); PG8_MMA(0, 0, At, B0); PG8_BAR; PG8_SCHED;
            PG8_LDB(B1, 0, 1); PG8_STAGE(PG8_SB(0, 0), b2, voffB);
            PG8_BAR; PG8_WAIT_L(0); PG8_MMA(0, 1, At, B1); PG8_BAR;
            PG8_LDA(At, 0, 1); PG8_STAGE(PG8_SA(0, 0), a2, voffA);
            PG8_BAR; PG8_WAIT_L(0); PG8_MMA(1, 0, At, B0); PG8_BAR; PG8_SCHED;
            PG8_STAGE(PG8_SB(0, 1), b2 + hstep, voffB);
            PG8_WAIT_V(6); PG8_BAR; PG8_MMA(1, 1, At, B1); PG8_BAR;
            PG8_LDB(B0, 1, 0); PG8_SCHED; PG8_LDA(At, 1, 0); PG8_STAGE(PG8_SA(0, 1), a2 + hstep, voffA);
            PG8_WAIT_L(8); PG8_BAR; PG8_WAIT_L(0); PG8_MMA(0, 0, At, B0); PG8_BAR; PG8_SCHED;
            PG8_LDB(B1, 1, 1); PG8_STAGE(PG8_SB(1, 0), b3, voffB);
            PG8_BAR; PG8_WAIT_L(0); PG8_MMA(0, 1, At, B1); PG8_BAR;
            PG8_LDA(At, 1, 1); PG8_STAGE(PG8_SA(1, 0), a3, voffA);
            PG8_BAR; PG8_WAIT_L(0); PG8_MMA(1, 0, At, B0); PG8_BAR; PG8_SCHED;
            PG8_STAGE(PG8_SB(1, 1), b3 + hstep, voffB);
            PG8_WAIT_V(6); PG8_BAR; PG8_MMA(1, 1, At, B1); PG8_BAR;
            }
        }
        if constexpr (ALIGN_EPI) { if (wr == 0) PG8_BAR; }
        if constexpr (!Epi::AFTER_DRAIN) { E(acc, cur, wr, wc, fr, fq); S.done(cur); }
        if (!has_next) break;
#pragma unroll
        for (int a = 0; a < 2; ++a)
#pragma unroll
            for (int b = 0; b < 2; ++b)
#pragma unroll
                for (int m = 0; m < 4; ++m)
#pragma unroll
                    for (int n = 0; n < 2; ++n) acc[a][b][m][n] = (f32x4){0.f, 0.f, 0.f, 0.f};
        cur = nxt; cA = nA; cB = nB; ++ui; nt = cur.nt;
        if constexpr (ALIGN_EPI) { if (wr == 1) PG8_BAR; }
    }
    PG8_WAIT_V(0);
    if constexpr (!ALIGN_EPI) { if (wr == 0) PG8_BAR; }
    PG8_BAR;
    if constexpr (Epi::AFTER_DRAIN) { E.fused(acc, cur, wr, wc, fr, fq, lds, wid, lane); S.done(cur); }
#undef PG8_SA
#undef PG8_SB
#undef PG8_STAGE
#undef PG8_LDA
#undef PG8_LDB
#undef PG8_MMA
#undef PG8_WAIT_V
#undef PG8_WAIT_L
#undef PG8_BAR
#undef PG8_SCHED
}
}

#define GAS __attribute__((address_space(1)))
#define LAS __attribute__((address_space(3)))
typedef unsigned short bf16_t;
typedef float f32x4 __attribute__((ext_vector_type(4)));
typedef float f32x16 __attribute__((ext_vector_type(16)));
typedef short bf16x8 __attribute__((ext_vector_type(8)));
typedef unsigned u32x4 __attribute__((ext_vector_type(4)));
typedef unsigned u32x2 __attribute__((ext_vector_type(2)));
using pg8::cvt_pk_bf16;

constexpr int DM = 1024, NB = 8, SEQ = 2048, CTXL = 256, DEPTH = 4;
constexpr int ML = NB * SEQ, MC = NB * CTXL, MT = ML + MC;
constexpr int DPROJ = 2048, DFF = 2816, NMOD = 6144, KT = 36;
constexpr float EPS = 1e-6f;
constexpr float LOG2E = 1.4426950408889634f;
constexpr float QSCALE = 0.125f * LOG2E;
constexpr float NEGBIG = -1e30f;

constexpr size_t MiB = 1u << 20;
constexpr size_t WS_CTL = 0, WS_WIN = 1 * MiB, WS_WOUT = 17 * MiB, WS_WUP = 25 * MiB, WS_WDN = 69 * MiB, WS_MOD = 91 * MiB, WS_ROPE = 92 * MiB,
                 WS_X = 93 * MiB, WS_H = 165 * MiB, WS_EDGE = 201 * MiB, WS_Q = 221 * MiB, WS_O = 257 * MiB, WS_K = 293 * MiB, WS_V = 311 * MiB,
                 WS_HID = 221 * MiB, WS_PB = 329 * MiB, WS_END = 345 * MiB;
constexpr size_t WS_GAIN = WS_MOD + 917504, WS_CP = WS_ROPE + 524288;
constexpr int CP_AN = 0, CP_FN = 4096, CP_RPB = 8192, CP_SINK = 15632, CP_FIN = 15648, CP_CONV = 16896;
constexpr int LDS_BYTES = 147456;

#define LDS_WAIT() asm volatile("s_waitcnt lgkmcnt(0)" ::: "memory")

#define XB_TMO      128
#define XB_XCNT(j)  (256  + 64 * (j))
#define XB_XSUB(j)  (1280 + 64 * (j))
#define XB_XGEN(j)  (2304 + 64 * (j))
#define XB_TOP      3328
#define XB_TOPGEN   3392
#define XCD_BAR_WORDS 3456
#define XB_SPIN_CAP (1u << 18)

__device__ __forceinline__ unsigned xb_ld(unsigned* p)              { return __hip_atomic_load(p, __ATOMIC_RELAXED, __HIP_MEMORY_SCOPE_AGENT); }
__device__ __forceinline__ unsigned xb_add(unsigned* p, unsigned v) { return __hip_atomic_fetch_add(p, v, __ATOMIC_RELAXED, __HIP_MEMORY_SCOPE_AGENT); }
__device__ __forceinline__ unsigned xb_xcc_id() { return (unsigned)__builtin_amdgcn_s_getreg((3 << 11) | 20) & 0xFu; }
#define XB_SPIN(cond, bar) do { unsigned _sp = 0; while (cond) { __builtin_amdgcn_s_sleep(1); \
    if ((++_sp & 255u) == 0u) { if (xb_ld(&(bar)[XB_TMO])) break; if (_sp > XB_SPIN_CAP) { atomicAdd(&(bar)[XB_TMO], 1u); break; } } } } while (0)

struct XcdBarrier {
    unsigned* bar; unsigned x;
    volatile LAS unsigned* st;
};

__device__ __forceinline__ XcdBarrier xcd_barrier_post(unsigned* bar, volatile LAS unsigned* st) {
    XcdBarrier b; b.bar = bar; b.x = xb_xcc_id(); b.st = st;
    if (threadIdx.x == 0) (void)xb_add(&bar[XB_XCNT(b.x)], 1u);
    return b;
}
__device__ __forceinline__ void xcd_barrier_complete(unsigned* bar, unsigned x, unsigned& nloc, unsigned& nx) {
    const unsigned G = gridDim.x * gridDim.y * gridDim.z;
    unsigned sum, cnt, mine, sp = 0u;
    for (;;) {
        sum = 0u; cnt = 0u; mine = 0u;
#pragma unroll
        for (unsigned j = 0; j < 16; ++j) { const unsigned c = xb_ld(&bar[XB_XCNT(j)]); sum += c; cnt += (c > 0u) ? 1u : 0u; mine = (j == x) ? c : mine; }
        if (sum == G) break;
        __builtin_amdgcn_s_sleep(1);
        if ((++sp & 255u) == 0u) { if (xb_ld(&bar[XB_TMO])) break; if (sp > XB_SPIN_CAP) { atomicAdd(&bar[XB_TMO], 1u); break; } }
    }
    nloc = mine > 0u ? mine : 1u; nx = cnt > 0u ? cnt : 1u;
}

__device__ __forceinline__ void xcd_barrier(const XcdBarrier& b) {
    asm volatile("s_waitcnt vmcnt(0)" ::: "memory");
    __syncthreads();
    if (threadIdx.x == 0) {
        unsigned* bar = b.bar;
        __builtin_amdgcn_s_waitcnt(0);
        unsigned nloc = b.st[0], nx = b.st[1];
        if (nloc == 0u) { xcd_barrier_complete(bar, b.x, nloc, nx); b.st[0] = nloc; b.st[1] = nx; }
        const unsigned old = xb_add(&bar[XB_XSUB(b.x)], 1u);
        const unsigned gen = old / nloc;
        if (old + 1u == (gen + 1u) * nloc) {
            __builtin_amdgcn_fence(__ATOMIC_RELEASE, "agent");
            asm volatile("s_waitcnt vmcnt(0)" ::: "memory");
            const unsigned og = xb_add(&bar[XB_TOP], 1u);
            const unsigned tg = og / nx;
            if (og + 1u == (tg + 1u) * nx) xb_add(&bar[XB_TOPGEN], 1u);
            else XB_SPIN(xb_ld(&bar[XB_TOPGEN]) == tg, bar);
            __builtin_amdgcn_fence(__ATOMIC_ACQUIRE, "agent");
            xb_add(&bar[XB_XGEN(b.x)], 1u);
            asm volatile("s_waitcnt vmcnt(0)" ::: "memory");
        } else {
            XB_SPIN(xb_ld(&bar[XB_XGEN(b.x)]) == gen, bar);
            __builtin_amdgcn_fence(__ATOMIC_ACQUIRE, "agent");
            asm volatile("s_waitcnt vmcnt(0)" ::: "memory");
        }
    }
    __syncthreads();
}

struct Args { const float* in[19]; float* out; unsigned char* ws; };

__device__ __forceinline__ float wave_sum(float v) {
#pragma unroll
    for (int o = 1; o < 64; o <<= 1) v += __shfl_xor(v, o);
    return v;
}
__device__ __forceinline__ float silu_f(float x) { return x * __builtin_amdgcn_rcpf(1.0f + __builtin_amdgcn_exp2f(-x * LOG2E)); }
__device__ __forceinline__ float dpp_ror1(float x)  { return __builtin_bit_cast(float, __builtin_amdgcn_update_dpp(0, __builtin_bit_cast(int, x), 0x121, 0xf, 0xf, false)); }
__device__ __forceinline__ float dpp_ror15(float x) { return __builtin_bit_cast(float, __builtin_amdgcn_update_dpp(0, __builtin_bit_cast(int, x), 0x12F, 0xf, 0xf, false)); }

__device__ __forceinline__ void tr_item(const float* W, int K, int N, bf16_t* WT, int k0, int src_n0, int dst_n0, LAS float* scr, int lane) {
#pragma unroll 8
    for (int i = 0; i < 32; ++i) { const int kk = 2 * i + (lane >> 5); scr[kk * 33 + (lane & 31)] = W[(size_t)(k0 + kk) * N + src_n0 + (lane & 31)]; }
    LDS_WAIT(); asm volatile("" ::: "memory");
    const int c = lane & 7;
#pragma unroll
    for (int j = 0; j < 4; ++j) { const int n = (lane >> 3) + 8 * j; const LAS float* s = scr + (8 * c) * 33 + n;
        u32x4 o; o.x = cvt_pk_bf16(s[0 * 33], s[1 * 33]); o.y = cvt_pk_bf16(s[2 * 33], s[3 * 33]); o.z = cvt_pk_bf16(s[4 * 33], s[5 * 33]); o.w = cvt_pk_bf16(s[6 * 33], s[7 * 33]);
        *(u32x4*)(WT + (size_t)(dst_n0 + n) * K + k0 + 8 * c) = o; }
    LDS_WAIT(); asm volatile("" ::: "memory");
}

__device__ __forceinline__ void prologue(const Args& a, LAS unsigned char* lds) {
    const int tid = threadIdx.x, lane = tid & 63, wave = tid >> 6;
    unsigned char* ws = a.ws;
    {
        LAS float* scr = (LAS float*)(lds + 49152 + wave * 8704);
        const int gw = blockIdx.x * 8 + wave, NGW = gridDim.x * 8;
        constexpr int I_IN = 16 * 64, I_OUT = 16 * 32, I_UP = 16 * 176, I_DN = 44 * 32, I_L = I_IN + I_OUT + I_UP + I_DN;
        for (int it = gw; it < DEPTH * I_L; it += NGW) {
            const int l = it / I_L; int r = it % I_L;
            if (r < I_IN) { const int kb = r / 64, nb = r % 64, pn = nb >> 3, p0 = (nb & 7) * 32;
                const int src = 256 * pn + 64 * ((p0 & 127) >> 5) + 32 * (p0 >> 7);
                tr_item(a.in[8] + (size_t)l * DM * DPROJ, DM, DPROJ, (bf16_t*)(ws + WS_WIN) + (size_t)l * DPROJ * DM, kb * 64, src, nb * 32, scr, lane); continue; }
            r -= I_IN;
            if (r < I_OUT) { const int kb = r / 32, nb = r % 32;
                tr_item(a.in[13] + (size_t)l * DM * DM, DM, DM, (bf16_t*)(ws + WS_WOUT) + (size_t)l * DM * DM, kb * 64, nb * 32, nb * 32, scr, lane); continue; }
            r -= I_OUT;
            if (r < I_UP) { const int kb = r / 176, nb = r % 176, pn = nb >> 3, p0 = (nb & 7) * 32;
                const int src = p0 < 128 ? 128 * pn + p0 : DFF + 128 * pn + p0 - 128;
                tr_item(a.in[14] + (size_t)l * DM * 2 * DFF, DM, 2 * DFF, (bf16_t*)(ws + WS_WUP) + (size_t)l * 2 * DFF * DM, kb * 64, src, nb * 32, scr, lane); continue; }
            r -= I_UP;
            { const int kb = r / 32, nb = r % 32;
                tr_item(a.in[17] + (size_t)l * DFF * DM, DFF, DM, (bf16_t*)(ws + WS_WDN) + (size_t)l * DM * DFF, kb * 64, nb * 32, nb * 32, scr, lane); }
        }
    }
    {
        float* cosT = (float*)(ws + WS_ROPE); float* sinT = cosT + SEQ * 32;
        for (int idx = blockIdx.x * 512 + tid; idx < SEQ * 32; idx += gridDim.x * 512) {
            const int t = idx >> 5, i = idx & 31, p = i & 15, pa = p >> 2, pb = p & 3;
            const int pos = i < 16 ? (t >> 6) : (t & 63);
            const double ia = pa == 0 ? 1.0 : pa == 1 ? 0.1 : pa == 2 ? 0.01 : 0.001;
            const double ib = pb == 0 ? 1.0 : pb == 1 ? 0.5623413251903491 : pb == 2 ? 0.31622776601683794 : 0.17782794100389228;
            const double x = (double)pos * (ia * ib);
            const double kq = __builtin_rint(x * 0.6366197723675814);
            const double r = (x - kq * 1.5707963267948966) - kq * 6.123233995736766e-17;
            const double r2 = r * r;
            const double sn = r * (1.0 + r2 * (-1.0 / 6 + r2 * (1.0 / 120 + r2 * (-1.0 / 5040 + r2 * (1.0 / 362880 + r2 * (-1.0 / 39916800 + r2 * (1.0 / 6227020800.0)))))));
            const double cs = 1.0 + r2 * (-0.5 + r2 * (1.0 / 24 + r2 * (-1.0 / 720 + r2 * (1.0 / 40320 + r2 * (-1.0 / 3628800 + r2 * (1.0 / 479001600 + r2 * (-1.0 / 87178291200.0)))))));
            const int q = ((int)kq) & 3;
            const double c = q == 0 ? cs : q == 1 ? -sn : q == 2 ? -cs : sn;
            const double s = q == 0 ? sn : q == 1 ? cs : q == 2 ? -sn : -cs;
            cosT[idx] = (float)c; sinT[idx] = (float)s;
        }
    }
    if (blockIdx.x == 0) { float* gains = (float*)(ws + WS_GAIN); const int l = tid >> 7, w = (tid >> 6) & 1, d = tid & 63; gains[tid] = w ? a.in[10][l * 64 + d] : a.in[9][l * 64 + d];
        if (tid < DEPTH) { float mq = 0.f, mk = 0.f; for (int d2 = 0; d2 < 64; ++d2) { mq = fmaxf(mq, fabsf(a.in[9][tid * 64 + d2])); mk = fmaxf(mk, fabsf(a.in[10][tid * 64 + d2])); }
            gains[512 + tid] = 64.0f * mq * mk * QSCALE * 1.02f; } }
    { float* cp = (float*)(ws + WS_CP); const int gt = blockIdx.x * 512 + tid, NT = gridDim.x * 512;
      for (int i = gt; i < 4096; i += NT) { cp[CP_AN + i] = a.in[4][i]; cp[CP_FN + i] = a.in[5][i]; }
      for (int i = gt; i < 7440; i += NT) cp[CP_RPB + i] = a.in[11][i];
      for (int i = gt; i < 16; i += NT) cp[CP_SINK + i] = a.in[12][i];
      for (int i = gt; i < 1024; i += NT) cp[CP_FIN + i] = a.in[18][i];
      for (int i = gt; i < DEPTH * 4 * DFF; i += NT) { const int l = i / (4 * DFF), r = i % (4 * DFF); cp[CP_CONV + i] = r < 3 * DFF ? a.in[15][l * 3 * DFF + r] : a.in[16][l * DFF + r - 3 * DFF]; } }
    {
        LAS float* ca = (LAS float*)lds;
        LAS float* red = (LAS float*)(lds + 36864);
        for (int idx = tid; idx < 9 * DM; idx += 512) { const int r = idx >> 10, k = idx & 1023; const float v = r < 8 ? a.in[1][r * DM + k] : a.in[3][k]; ca[idx] = v / (1.0f + expf(-v)); }
        __syncthreads();
        float* mod = (float*)(ws + WS_MOD);
        const int c4 = lane & 7, kr = lane >> 3;
        for (int item = blockIdx.x; item < DEPTH * 192; item += gridDim.x) {
            const int l = item / 192, col0 = (item % 192) * 32;
            f32x4 acc[9];
#pragma unroll
            for (int r = 0; r < 9; ++r) acc[r] = (f32x4){0.f, 0.f, 0.f, 0.f};
            const float* wp = a.in[6] + ((size_t)l * DM + wave * 128 + kr) * NMOD + col0 + 4 * c4;
#pragma unroll 4
            for (int i = 0; i < 16; ++i) { const f32x4 wv = *(const f32x4*)(wp + (size_t)i * 8 * NMOD); const int k = wave * 128 + 8 * i + kr;
#pragma unroll
                for (int r = 0; r < 9; ++r) acc[r] += ca[r * DM + k] * wv; }
#pragma unroll
            for (int r = 0; r < 9; ++r)
#pragma unroll
                for (int j = 0; j < 4; ++j) { float v = acc[r][j]; v += __shfl_xor(v, 8); v += __shfl_xor(v, 16); v += __shfl_xor(v, 32); acc[r][j] = v; }
            if (kr == 0) {
#pragma unroll
                for (int r = 0; r < 9; ++r) *(LAS f32x4*)(red + (wave * 9 + r) * 32 + 4 * c4) = acc[r]; }
            __syncthreads();
            if (tid < 288) { const int r = tid >> 5, ci = tid & 31; float s = a.in[7][l * NMOD + col0 + ci];
#pragma unroll
                for (int w = 0; w < 8; ++w) s += red[(w * 9 + r) * 32 + ci];
                mod[((size_t)l * 9 + r) * NMOD + col0 + ci] = s; }
            __syncthreads();
        }
    }
}

__device__ __forceinline__ void norm_phase(const float* srcL, const float* srcC, float* xcopy, const float* g, const float* modl, int shoff, int scoff, bf16_t* H, int nrows, const bf16_t* PB = nullptr) {
    int tid_l = threadIdx.x; asm volatile("" : "+v"(tid_l));
    const int lane = tid_l & 63, wave = tid_l >> 6;
    const int gw = blockIdx.x * 8 + wave, NGW = gridDim.x * 8;
    for (int row = gw; row < nrows; row += NGW) {
        const float* src = row < ML ? srcL + (size_t)row * DM : srcC + (size_t)(row - ML) * DM;
        const int bidx = row < ML ? row >> 11 : 8;
        const float* mr = modl + (size_t)bidx * NMOD;
        f32x4 v[4]; float ss = 0.f;
#pragma unroll
        for (int j = 0; j < 4; ++j) { v[j] = *(const f32x4*)(src + 4 * (64 * j + lane));
            if (PB && row >= ML) { const size_t o = (size_t)(row - ML) * DM + 4 * (64 * j + lane);
#pragma unroll
                for (int sl = 0; sl < 4; ++sl) { const u32x2 w = *(const u32x2*)(PB + (size_t)sl * MC * DM + o);
                    v[j].x += __uint_as_float(w.x << 16); v[j].y += __uint_as_float(w.x & 0xffff0000u); v[j].z += __uint_as_float(w.y << 16); v[j].w += __uint_as_float(w.y & 0xffff0000u); }
                *(f32x4*)(const_cast<float*>(src) + 4 * (64 * j + lane)) = v[j]; }
            ss += (v[j].x * v[j].x + v[j].y * v[j].y) + (v[j].z * v[j].z + v[j].w * v[j].w); }
        const float rstd = 1.0f / sqrtf(wave_sum(ss) * (1.0f / DM) + EPS);
#pragma unroll
        for (int j = 0; j < 4; ++j) { const int c = 4 * (64 * j + lane);
            const f32x4 gv = *(const f32x4*)(g + c), sc = *(const f32x4*)(mr + scoff + c), sh = *(const f32x4*)(mr + shoff + c);
            const f32x4 y = (v[j] * rstd) * gv * (1.0f + sc) + sh;
            u32x2 o; o.x = cvt_pk_bf16(y.x, y.y); o.y = cvt_pk_bf16(y.z, y.w);
            *(u32x2*)(H + (size_t)row * DM + c) = o;
            if (xcopy && (row >= ML || gridDim.x != 256)) *(f32x4*)(xcopy + (size_t)row * DM + c) = v[j]; }
    }
}
__device__ __forceinline__ void final_norm_phase(const float* X, const float* g, float* out) {
    const int lane = threadIdx.x & 63, wave = threadIdx.x >> 6;
    const int gw = blockIdx.x * 8 + wave, NGW = gridDim.x * 8;
    for (int row = gw; row < ML; row += NGW) {
        const float* src = X + (size_t)row * DM;
        f32x4 v[4]; float ss = 0.f;
#pragma unroll
        for (int j = 0; j < 4; ++j) { v[j] = *(const f32x4*)(src + 4 * (64 * j + lane)); ss += (v[j].x * v[j].x + v[j].y * v[j].y) + (v[j].z * v[j].z + v[j].w * v[j].w); }
        const float rstd = 1.0f / sqrtf(wave_sum(ss) * (1.0f / DM) + EPS);
#pragma unroll
        for (int j = 0; j < 4; ++j) { const int c = 4 * (64 * j + lane); const f32x4 gv = *(const f32x4*)(g + c);
            *(f32x4*)(out + (size_t)row * DM + c) = (v[j] * rstd) * gv; }
    }
}

struct EpiQKV {
    static constexpr bool PERM = true, AFTER_DRAIN = false;
    bf16_t* Q; bf16_t* Kf; bf16_t* Vf; const float* gains; const float* cosT; const float* sinT;
    __device__ __forceinline__ void operator()(const pg8::f32x4 (&acc)[2][2][4][2], const pg8::Unit& u, int wr_, int wc_, int fr_, int fq_) const {
        int wr = wr_, wc = wc_, fr = fr_, fq = fq_; asm volatile("" : "+s"(wr), "+s"(wc), "+v"(fr), "+v"(fq));
        const int pn = u.pn, pm = u.pm;
        int kind = 0, head = 0, nrm = 0, rope = 0;
        if (pn == 0) { kind = 0; head = wc; }
        else if (pn == 1) { kind = 1; head = wc; }
        else if (pn == 2) { kind = 2; head = wc; }
        else if (pn == 3 || pn == 4) { kind = 0; head = 4 * (pn - 2) + wc; nrm = 1; rope = 1; }
        else if (pn == 5) { if (wc < 2) { kind = 1; head = 4 + wc; nrm = 2; rope = 1; } else { kind = 2; head = 2 + wc; } }
        else if (pn == 6) { kind = 0; head = 12 + wc; rope = 1; }
        else { if (wc < 2) { kind = 1; head = 6 + wc; rope = 1; } else { kind = 2; head = 4 + wc; } }
        const bool latent = pm < 64;
        const int b = latent ? (pm >> 3) : (pm - 64);
        const int tile0 = latent ? (pm & 7) * 4 : 32;
        const int s0 = latent ? (pm & 7) * 256 : 0;
        if (!latent) rope = 0;
        const float* gp = gains + (nrm == 2 ? 64 : 0) + 8 * fq;
#pragma unroll
        for (int ai = 0; ai < 2; ++ai)
#pragma unroll
            for (int m = 0; m < 4; ++m) {
                const int rl = 128 * ai + 64 * wr + 16 * m + fr;
                f32x4 v[2][2];
#pragma unroll
                for (int bj = 0; bj < 2; ++bj)
#pragma unroll
                    for (int n = 0; n < 2; ++n) v[bj][n] = acc[ai][bj][m][n];
                if (nrm) {
                    float ss = 0.f;
#pragma unroll
                    for (int bj = 0; bj < 2; ++bj)
#pragma unroll
                        for (int n = 0; n < 2; ++n) ss += (v[bj][n].x * v[bj][n].x + v[bj][n].y * v[bj][n].y) + (v[bj][n].z * v[bj][n].z + v[bj][n].w * v[bj][n].w);
                    ss += __shfl_xor(ss, 16); ss += __shfl_xor(ss, 32);
                    const float rs = 1.0f / sqrtf(ss * (1.0f / 64.0f) + EPS);
#pragma unroll
                    for (int bj = 0; bj < 2; ++bj)
#pragma unroll
                        for (int n = 0; n < 2; ++n) v[bj][n] = (v[bj][n] * rs) * *(const f32x4*)(gp + 32 * bj + 4 * n);
                }
                if (rope) {
                    const int s = s0 + rl;
#pragma unroll
                    for (int n = 0; n < 2; ++n) {
                        const f32x4 cs = *(const f32x4*)(cosT + s * 32 + 8 * fq + 4 * n), sn = *(const f32x4*)(sinT + s * 32 + 8 * fq + 4 * n);
                        const f32x4 x1 = v[0][n], x2 = v[1][n];
                        v[0][n] = x1 * cs - x2 * sn; v[1][n] = x1 * sn + x2 * cs; }
                }
                if (kind == 0) {
#pragma unroll
                    for (int bj = 0; bj < 2; ++bj) { const f32x4 a0 = v[bj][0] * QSCALE, a1 = v[bj][1] * QSCALE;
                        u32x4 w; w.x = cvt_pk_bf16(a0.x, a0.y); w.y = cvt_pk_bf16(a0.z, a0.w); w.z = cvt_pk_bf16(a1.x, a1.y); w.w = cvt_pk_bf16(a1.z, a1.w);
                        *(u32x4*)(Q + (size_t)(pm * 256 + rl) * DM + head * 64 + bj * 32 + 8 * fq) = w; }
                } else if (kind == 1) {
                    bf16_t* base = Kf + ((size_t)((b * 8 + head) * KT + tile0 + 2 * ai + wr)) * 4096;
                    const int kblk = m >> 1, r32 = 16 * (m & 1) + fr;
#pragma unroll
                    for (int bj = 0; bj < 2; ++bj) { const int d0 = 2 * bj + (fq >> 1), hi = fq & 1;
                        u32x4 w; w.x = cvt_pk_bf16(v[bj][0].x, v[bj][0].y); w.y = cvt_pk_bf16(v[bj][0].z, v[bj][0].w); w.z = cvt_pk_bf16(v[bj][1].x, v[bj][1].y); w.w = cvt_pk_bf16(v[bj][1].z, v[bj][1].w);
                        *(u32x4*)(base + ((kblk * 4 + d0) * 64 + hi * 32 + r32) * 8) = w; }
                } else {
                    bf16_t* base = Vf + ((size_t)((b * 8 + head) * KT + tile0 + 2 * ai + wr)) * 4096;
#pragma unroll
                    for (int bj = 0; bj < 2; ++bj) {
                        u32x4 w; w.x = cvt_pk_bf16(v[bj][0].x, v[bj][0].y); w.y = cvt_pk_bf16(v[bj][0].z, v[bj][0].w); w.z = cvt_pk_bf16(v[bj][1].x, v[bj][1].y); w.w = cvt_pk_bf16(v[bj][1].z, v[bj][1].w);
                        *(u32x4*)(base + ((4 * m + (fr >> 2)) * 4 + 2 * bj + (fq >> 1)) * 64 + (fr & 3) * 16 + (fq & 1) * 8) = w; }
                }
                if (m & 1) asm volatile("" ::: "memory");
            }
    }
};

struct EpiRes {
    static constexpr bool PERM = false, AFTER_DRAIN = false;
    float* X; const float* Xin; const float* modl; int goff; bf16_t* PB;
    __device__ __forceinline__ void operator()(const pg8::f32x4 (&acc)[2][2][4][2], const pg8::Unit& u, int wr_, int wc_, int fr_, int fq_) const {
        int wr = wr_, wc = wc_, fr = fr_, fq = fq_; asm volatile("" : "+s"(wr), "+s"(wc), "+v"(fr), "+v"(fq));
        const int bidx = u.pm < 64 ? (u.pm >> 3) : 8;
        const float* gate = modl + (size_t)bidx * NMOD + goff;
        const int c0 = u.pn * 256 + wc * 32 + 4 * fq;
        f32x4 gv[2][2];
#pragma unroll
        for (int bj = 0; bj < 2; ++bj)
#pragma unroll
            for (int n = 0; n < 2; ++n) gv[bj][n] = *(const f32x4*)(gate + c0 + 128 * bj + 16 * n);
        if (u.part) {
            bf16_t* pb = PB + (size_t)(u.part - 1) * MC * DM;
#pragma unroll
            for (int ai = 0; ai < 2; ++ai)
#pragma unroll
                for (int m = 0; m < 4; ++m) { bf16_t* pr = pb + (size_t)((u.pm - 64) * 256 + 128 * ai + 64 * wr + 16 * m + fr) * DM + c0;
#pragma unroll
                    for (int bj = 0; bj < 2; ++bj)
#pragma unroll
                        for (int n = 0; n < 2; ++n) { const f32x4 v = gv[bj][n] * acc[ai][bj][m][n]; u32x2 o; o.x = cvt_pk_bf16(v.x, v.y); o.y = cvt_pk_bf16(v.z, v.w); *(u32x2*)(pr + 128 * bj + 16 * n) = o; } }
            return;
        }
#pragma unroll
        for (int ai = 0; ai < 2; ++ai)
#pragma unroll
            for (int m = 0; m < 4; ++m) { const size_t ro = (size_t)(u.pm * 256 + 128 * ai + 64 * wr + 16 * m + fr) * DM + c0; float* xr = X + ro; const float* xi = Xin + ro;
#pragma unroll
                for (int bj = 0; bj < 2; ++bj)
#pragma unroll
                    for (int n = 0; n < 2; ++n) { *(f32x4*)(xr + 128 * bj + 16 * n) = *(const f32x4*)(xi + 128 * bj + 16 * n) + gv[bj][n] * acc[ai][bj][m][n]; }
                if (m & 1) asm volatile("" ::: "memory"); }

    }
};

struct EpiUp {
    static constexpr bool PERM = true, AFTER_DRAIN = false;
    bf16_t* HID; float* EDGE; const float* cw; const float* cb;
    __device__ __forceinline__ void operator()(const pg8::f32x4 (&acc)[2][2][4][2], const pg8::Unit& u, int wr_, int wc_, int fr_, int fq_) const {
        int wr = wr_, wc = wc_, fr = fr_, fq = fq_; asm volatile("" : "+s"(wr), "+s"(wc), "+v"(fr), "+v"(fq));
        const int col0 = 128 * u.pn + 32 * wc + 8 * fq;
        f32x4 w0[2], w1[2], w2[2], bb[2];
#pragma unroll
        for (int n = 0; n < 2; ++n) { w0[n] = *(const f32x4*)(cw + col0 + 4 * n); w1[n] = *(const f32x4*)(cw + DFF + col0 + 4 * n); w2[n] = *(const f32x4*)(cw + 2 * DFF + col0 + 4 * n); bb[n] = *(const f32x4*)(cb + col0 + 4 * n); }
#pragma unroll
        for (int ai = 0; ai < 2; ++ai) {
            const int g = u.pm * 4 + 2 * ai + wr;
#pragma unroll
            for (int m = 0; m < 4; ++m) {
                const int row = u.pm * 256 + 128 * ai + 64 * wr + 16 * m + fr;
                f32x4 cv[2];
#pragma unroll
                for (int n = 0; n < 2; ++n) {
                    const f32x4 av = acc[ai][0][m][n];
                    f32x4 pv, nv;
#pragma unroll
                    for (int j = 0; j < 4; ++j) {
                        const float p1 = dpp_ror1(av[j]); const float p2 = m > 0 ? dpp_ror1(acc[ai][0][m > 0 ? m - 1 : 0][n][j]) : 0.f;
                        pv[j] = fr == 0 ? p2 : p1;
                        const float n1 = dpp_ror15(av[j]); const float n2 = m < 3 ? dpp_ror15(acc[ai][0][m < 3 ? m + 1 : 3][n][j]) : 0.f;
                        nv[j] = fr == 15 ? n2 : n1; }
                    cv[n] = w1[n] * av + bb[n] + w0[n] * pv + w2[n] * nv;
                }
                const bool first = (m == 0 && fr == 0), lastr = (m == 3 && fr == 15);
                if (first || lastr) {
                    float* e = EDGE + ((size_t)(g * 2 + (lastr ? 1 : 0)) * 3) * DFF + col0;
#pragma unroll
                    for (int n = 0; n < 2; ++n) { *(f32x4*)(e + 4 * n) = acc[ai][0][m][n]; *(f32x4*)(e + DFF + 4 * n) = cv[n]; *(f32x4*)(e + 2 * DFF + 4 * n) = acc[ai][1][m][n]; }
                } else {
                    f32x4 h0, h1;
#pragma unroll
                    for (int j = 0; j < 4; ++j) { h0[j] = silu_f(cv[0][j]) * acc[ai][1][m][0][j]; h1[j] = silu_f(cv[1][j]) * acc[ai][1][m][1][j]; }
                    u32x4 w; w.x = cvt_pk_bf16(h0.x, h0.y); w.y = cvt_pk_bf16(h0.z, h0.w); w.z = cvt_pk_bf16(h1.x, h1.y); w.w = cvt_pk_bf16(h1.z, h1.w);
                    __builtin_nontemporal_store(w, (u32x4*)(HID + (size_t)row * DFF + col0));
                }
            }
        }
    }
};

__device__ __forceinline__ void fixup_phase(const float* EDGE, const float* cw, bf16_t* HID, int ngroups) {
    const int total = ngroups * 2 * (DFF / 4);
    for (int idx = blockIdx.x * 512 + threadIdx.x; idx < total; idx += gridDim.x * 512) {
        const int c4 = idx % (DFF / 4), gw = idx / (DFF / 4), which = gw & 1, g = gw >> 1, col = 4 * c4;
        const int seqg = g < 256 ? 32 : 4;
        const float* e = EDGE + ((size_t)(g * 2 + which) * 3) * DFF + col;
        f32x4 part = *(const f32x4*)(e + DFF); const f32x4 bv = *(const f32x4*)(e + 2 * DFF);
        if (which == 0) { if (g % seqg != 0) part += *(const f32x4*)(cw + col) * *(const f32x4*)(EDGE + ((size_t)((g - 1) * 2 + 1) * 3) * DFF + col); }
        else { if ((g + 1) % seqg != 0) part += *(const f32x4*)(cw + 2 * DFF + col) * *(const f32x4*)(EDGE + ((size_t)((g + 1) * 2) * 3) * DFF + col); }
        u32x2 o; o.x = cvt_pk_bf16(silu_f(part.x) * bv.x, silu_f(part.y) * bv.y); o.y = cvt_pk_bf16(silu_f(part.z) * bv.z, silu_f(part.w) * bv.w);
        *(u32x2*)(HID + (size_t)(64 * g + (which ? 63 : 0)) * DFF + col) = o;
    }
}

__device__ __forceinline__ void fixup_tile(const float* EDGE, const float* cw, bf16_t* HID, int g0) {
    for (int idx = threadIdx.x; idx < 4 * 2 * (DFF / 4); idx += 512) {
        const int c4 = idx % (DFF / 4), gw = idx / (DFF / 4), which = gw & 1, g = g0 + (gw >> 1), col = 4 * c4;
        const int seqg = g < 256 ? 32 : 4;
        const float* e = EDGE + ((size_t)(g * 2 + which) * 3) * DFF + col;
        f32x4 part = *(const f32x4*)(e + DFF); const f32x4 bv = *(const f32x4*)(e + 2 * DFF);
        if (which == 0) { if (g % seqg != 0) part += *(const f32x4*)(cw + col) * *(const f32x4*)(EDGE + ((size_t)((g - 1) * 2 + 1) * 3) * DFF + col); }
        else { if ((g + 1) % seqg != 0) part += *(const f32x4*)(cw + 2 * DFF + col) * *(const f32x4*)(EDGE + ((size_t)((g + 1) * 2) * 3) * DFF + col); }
        u32x2 o; o.x = cvt_pk_bf16(silu_f(part.x) * bv.x, silu_f(part.y) * bv.y); o.y = cvt_pk_bf16(silu_f(part.z) * bv.z, silu_f(part.w) * bv.w);
        *(u32x2*)(HID + (size_t)(64 * g + (which ? 63 : 0)) * DFF + col) = o;
    }
}

struct AttnP { const bf16_t* Q; bf16_t* O; const bf16_t* Kf; const bf16_t* Vf; const float* rpb; const float* sink; unsigned* counter; int nunits; float bbound; unsigned* xq; };

typedef short v4i16_t __attribute__((ext_vector_type(4)));
typedef float f32x2 __attribute__((ext_vector_type(2)));
__device__ __forceinline__ float half_max(float m) { auto rr = __builtin_amdgcn_permlane32_swap(__float_as_uint(m), __float_as_uint(m), false, false); return fmaxf(__uint_as_float(rr[0]), __uint_as_float(rr[1])); }
__device__ __forceinline__ float half_sum(float m) { auto rr = __builtin_amdgcn_permlane32_swap(__float_as_uint(m), __float_as_uint(m), false, false); return __uint_as_float(rr[0]) + __uint_as_float(rr[1]); }
#define MX3(a, b, c) __builtin_fmaxf(__builtin_fmaxf((a), (b)), (c))

__device__ __forceinline__ void glds16(const void* gsrc, unsigned lds_dst) { unsigned keep;
    asm volatile("s_mov_b32 %0, m0\n\ts_mov_b32 m0, %2\n\ts_nop 0\n\tglobal_load_lds_dwordx4 %1, off\n\ts_mov_b32 m0, %0" : "=&s"(keep) : "v"(gsrc), "s"(lds_dst) : "memory"); }
template <int MODE, bool NM = false> __device__ __forceinline__ void attn_unit(LAS unsigned char* lds, const AttnP& P, int b, int qhead, int kvh, int qpos0, int qrow0, int tlo, int thi, int sinkidx) {
    int tid_l = threadIdx.x; asm volatile("" : "+v"(tid_l));
    const int tid = tid_l, lane = tid & 63, wid = __builtin_amdgcn_readfirstlane(tid >> 6), r32 = lane & 31, hi = lane >> 5;
    constexpr int RM = (MODE == 0) ? 7 : 3;
    LAS unsigned char* ldsK = lds; LAS unsigned char* ldsV = lds + (MODE == 0 ? 65536 : 32768);
    LAS float* tab = (LAS float*)(lds + 65536);
    volatile LAS int* qw = (volatile LAS int*)(lds + 65536 + 4096);
    const unsigned ldsK0 = (unsigned)(size_t)ldsK, ldsV0 = (unsigned)(size_t)ldsV;
    const int vlane = hi * 512 + ((lane >> 4) & 1) * 128 + ((lane & 15) >> 2) * 32 + (lane & 3) * 8;
    constexpr float THR = 8.0f;
    {
        const int nsteps = 4 + (thi - tlo);
        const bf16_t* kbase = P.Kf + (size_t)((b * 8 + kvh) * KT) * 4096 + tid * 8;
        const bf16_t* vbase = P.Vf + (size_t)((b * 8 + kvh) * KT) * 4096 + tid * 8;
        bf16x8 qf[4];
        { const bf16_t* qp = P.Q + (size_t)(qrow0 + wid * 32 + r32) * DM + qhead * 64 + hi * 8;
#pragma unroll
          for (int d0 = 0; d0 < 4; ++d0) qf[d0] = *(const bf16x8*)(qp + d0 * 16); }
        if (MODE == 1) { for (int i = tid; i < 15 * 31; i += 512) tab[i] = P.rpb[qhead * 465 + i] * LOG2E; }
        const int qw0 = qpos0 + wid * 32;
        const int qpos = qw0 + r32;
        float mref = 0.f, lrun = 0.f;
        f32x16 o0, o1, negm;
#pragma unroll
        for (int i = 0; i < 16; ++i) { o0[i] = 0.f; o1[i] = 0.f; negm[i] = 0.f; }
#define ATT_TILE(s_) ((s_) < 4 ? 32 + (s_) : tlo + (s_) - 4)
#define ATT_DMA(s_) do { const int tt_ = ATT_TILE(s_); const unsigned sl_ = (unsigned)(((s_) & RM) * 8192 + wid * 1024); \
            glds16(kbase + (size_t)tt_ * 4096, (unsigned)__builtin_amdgcn_readfirstlane(ldsK0 + sl_)); \
            glds16(vbase + (size_t)tt_ * 4096, (unsigned)__builtin_amdgcn_readfirstlane(ldsV0 + sl_)); } while (0)
        ATT_DMA(0); ATT_DMA(1); ATT_DMA(2);
        if (MODE == 0) { ATT_DMA(3); if (4 < nsteps) ATT_DMA(4); if (5 < nsteps) ATT_DMA(5); }
        asm volatile("s_waitcnt vmcnt(0)" : "+v"(qf[0]), "+v"(qf[1]), "+v"(qf[2]), "+v"(qf[3]) :: "memory");
        for (int st = 0; st < nsteps; ++st) {
            if (MODE == 0) {
                if ((st & 1) == 0) {
                    const int ahead = nsteps - 2 - st;
                    if (ahead >= 4) asm volatile("s_waitcnt vmcnt(8)" ::: "memory"); else if (ahead >= 2) asm volatile("s_waitcnt vmcnt(4)" ::: "memory"); else asm volatile("s_waitcnt vmcnt(0)" ::: "memory");
                    asm volatile("s_waitcnt lgkmcnt(0)" ::: "memory");
                    __builtin_amdgcn_s_barrier();
                    asm volatile("" ::: "memory");
                    if (st + 6 < nsteps) ATT_DMA(st + 6);
                    if (st + 7 < nsteps) ATT_DMA(st + 7); }
            } else {
            const int rem = nsteps - 1 - st;
            if (rem >= 2) asm volatile("s_waitcnt vmcnt(4)" ::: "memory"); else if (rem == 1) asm volatile("s_waitcnt vmcnt(2)" ::: "memory"); else asm volatile("s_waitcnt vmcnt(0)" ::: "memory");
            asm volatile("s_waitcnt lgkmcnt(0)" ::: "memory");
            __builtin_amdgcn_s_barrier();
            asm volatile("" ::: "memory");
            if (st + 3 < nsteps) ATT_DMA(st + 3);
            }
            const int t = ATT_TILE(st);
            const int buf = st & RM;
            bool skip = false;
            if (st >= 4) {
                if (MODE == 1) { const int qr = qw0 >> 6, rs = min(max(qr - 4, 0), 24); skip = (t < rs) || (t >= rs + 8); }
                else if (MODE == 2) { skip = (64 * t > qw0 + 31 + 128) || (64 * t + 63 < qw0 - 128); }
            }
            if (!skip) {
            const LAS unsigned char* kb = ldsK + buf * 8192 + lane * 16;
            const LAS unsigned char* vb = ldsV + buf * 8192 + vlane;
            f32x16 s0, s1;
            {
                bf16x8 kf[8];
#pragma unroll
                for (int i = 0; i < 8; ++i) kf[i] = *(const LAS bf16x8*)(kb + i * 1024);
                __builtin_amdgcn_sched_barrier(0);
                if (NM) { const f32x16 z = {0.f, 0.f, 0.f, 0.f, 0.f, 0.f, 0.f, 0.f, 0.f, 0.f, 0.f, 0.f, 0.f, 0.f, 0.f, 0.f};
                    s0 = __builtin_amdgcn_mfma_f32_32x32x16_bf16(kf[0], qf[0], z, 0, 0, 0); s1 = __builtin_amdgcn_mfma_f32_32x32x16_bf16(kf[4], qf[0], z, 0, 0, 0); }
                else { s0 = __builtin_amdgcn_mfma_f32_32x32x16_bf16(kf[0], qf[0], negm, 0, 0, 0); s1 = __builtin_amdgcn_mfma_f32_32x32x16_bf16(kf[4], qf[0], negm, 0, 0, 0); }
#pragma unroll
                for (int d0 = 1; d0 < 4; ++d0) { s0 = __builtin_amdgcn_mfma_f32_32x32x16_bf16(kf[d0], qf[d0], s0, 0, 0, 0); s1 = __builtin_amdgcn_mfma_f32_32x32x16_bf16(kf[4 + d0], qf[d0], s1, 0, 0, 0); }
                __builtin_amdgcn_sched_barrier(0);
            }
            v4i16_t vlo[8], vhi[8];
#pragma unroll
            for (int i = 0; i < 8; ++i) { vlo[i] = __builtin_amdgcn_ds_read_tr16_b64_v4i16((LAS v4i16_t*)(vb + (i & 3) * 2048 + (i >> 2) * 256));
                                          vhi[i] = __builtin_amdgcn_ds_read_tr16_b64_v4i16((LAS v4i16_t*)(vb + (i & 3) * 2048 + (i >> 2) * 256 + 1024)); }
            __builtin_amdgcn_sched_barrier(0);
            if (st >= 4) {
                if (MODE == 2 && !((64 * t >= qw0 + 31 - 128) && (64 * t + 63 <= qw0 + 128))) {
                    const int base = qpos - 64 * t - 4 * hi;
#pragma unroll
                    for (int i = 0; i < 16; ++i) { const int d = base - ((i & 3) + 8 * (i >> 2));
                        if (d > 128 || d < -128) s0[i] = NEGBIG;
                        if (d - 32 > 128 || d - 32 < -128) s1[i] = NEGBIG;
                        if ((i & 3) == 3) asm volatile("" : "+v"(s0), "+v"(s1)); }
                } else if (MODE == 1) {
                    const int qr = qpos >> 6, qc = qpos & 63;
                    const int cs = min(max(qc - 8, 0), 48);
                    const int tb = (t - qr + 7) * 31 + 15 - qc;
#pragma unroll
                    for (int i = 0; i < 16; ++i) { const int kk = 4 * hi + (i & 3) + 8 * (i >> 2);
                        const bool ok0 = kk >= cs && kk < cs + 16;
                        const bool ok1 = kk + 32 >= cs && kk + 32 < cs + 16;
                        int i0_ = ok0 ? tb + kk : 0, i1_ = ok1 ? tb + kk + 32 : 0; asm volatile("" : "+v"(i0_), "+v"(i1_));
                        const float b0 = tab[i0_], b1 = tab[i1_];
                        s0[i] = ok0 ? s0[i] + b0 : NEGBIG; s1[i] = ok1 ? s1[i] + b1 : NEGBIG;
                        if ((i & 3) == 3) asm volatile("" ::: "memory"); }
                }
            }
            if (!NM) {
            float ma = MX3(s0[0], s0[1], s1[0]), mb = MX3(s0[2], s0[3], s1[1]); ma = MX3(ma, s1[2], s1[3]);
#pragma unroll
            for (int r = 4; r < 16; r += 4) { ma = MX3(ma, s0[r], s0[r + 1]); mb = MX3(mb, s0[r + 2], s0[r + 3]); ma = MX3(ma, s1[r], s1[r + 1]); mb = MX3(mb, s1[r + 2], s1[r + 3]); }
            const float mx = half_max(fmaxf(ma, mb));
            if (st == 0) {
                mref = mx;
#pragma unroll
                for (int i = 0; i < 16; ++i) { s0[i] -= mx; s1[i] -= mx; negm[i] = -mx; }
            } else if (__any(mx > THR)) {
                const float dl = fmaxf(mx, 0.f); mref += dl;
                const float f = __builtin_amdgcn_exp2f(-dl); lrun *= f;
#pragma unroll
                for (int i = 0; i < 16; ++i) { s0[i] -= dl; s1[i] -= dl; negm[i] = -mref; o0[i] *= f; o1[i] *= f; }
            }
            }
            float lsa = 0.f, lsb = 0.f;
#pragma unroll
            for (int i = 0; i < 16; i += 2) { s0[i] = __builtin_amdgcn_exp2f(s0[i]); s0[i + 1] = __builtin_amdgcn_exp2f(s0[i + 1]); s1[i] = __builtin_amdgcn_exp2f(s1[i]); s1[i + 1] = __builtin_amdgcn_exp2f(s1[i + 1]);
                lsa += s0[i]; lsb += s0[i + 1]; asm volatile("" : "+v"(lsa), "+v"(lsb)); lsa += s1[i]; lsb += s1[i + 1]; asm volatile("" : "+v"(lsa), "+v"(lsb)); }
            lrun += lsa + lsb;
            u32x4 pw[4];
#pragma unroll
            for (int c = 0; c < 2; ++c) {
                pw[c].x = cvt_pk_bf16(s0[8 * c + 0], s0[8 * c + 1]); pw[c].y = cvt_pk_bf16(s0[8 * c + 2], s0[8 * c + 3]); pw[c].z = cvt_pk_bf16(s0[8 * c + 4], s0[8 * c + 5]); pw[c].w = cvt_pk_bf16(s0[8 * c + 6], s0[8 * c + 7]);
                pw[2 + c].x = cvt_pk_bf16(s1[8 * c + 0], s1[8 * c + 1]); pw[2 + c].y = cvt_pk_bf16(s1[8 * c + 2], s1[8 * c + 3]); pw[2 + c].z = cvt_pk_bf16(s1[8 * c + 4], s1[8 * c + 5]); pw[2 + c].w = cvt_pk_bf16(s1[8 * c + 6], s1[8 * c + 7]); }
            __builtin_amdgcn_sched_barrier(0);
#pragma unroll
            for (int c = 0; c < 4; ++c) {
                const bf16x8 v0 = (bf16x8){vlo[c][0], vlo[c][1], vlo[c][2], vlo[c][3], vhi[c][0], vhi[c][1], vhi[c][2], vhi[c][3]};
                const bf16x8 v1 = (bf16x8){vlo[4 + c][0], vlo[4 + c][1], vlo[4 + c][2], vlo[4 + c][3], vhi[4 + c][0], vhi[4 + c][1], vhi[4 + c][2], vhi[4 + c][3]};
                const bf16x8 pf = __builtin_bit_cast(bf16x8, pw[c]);
                o0 = __builtin_amdgcn_mfma_f32_32x32x16_bf16(v0, pf, o0, 0, 0, 0);
                o1 = __builtin_amdgcn_mfma_f32_32x32x16_bf16(v1, pf, o1, 0, 0, 0); }
            }
        }
        lrun = half_sum(lrun);
        if (sinkidx >= 0) lrun += __builtin_amdgcn_exp2f(P.sink[sinkidx] * LOG2E - mref);
        const float inv = 1.0f / lrun;
        bf16_t* op = P.O + (size_t)(qrow0 + wid * 32 + r32) * DM + qhead * 64 + 4 * hi;
#pragma unroll
        for (int g = 0; g < 4; ++g) {
            u32x2 w; w.x = cvt_pk_bf16(o0[4 * g] * inv, o0[4 * g + 1] * inv); w.y = cvt_pk_bf16(o0[4 * g + 2] * inv, o0[4 * g + 3] * inv);
            *(u32x2*)(op + 8 * g) = w;
            u32x2 w2; w2.x = cvt_pk_bf16(o1[4 * g] * inv, o1[4 * g + 1] * inv); w2.y = cvt_pk_bf16(o1[4 * g + 2] * inv, o1[4 * g + 3] * inv);
            *(u32x2*)(op + 32 + 8 * g) = w2; }
        __syncthreads();
    }
}

__device__ __forceinline__ void attn_phase(LAS unsigned char* lds, const AttnP P) {
    volatile LAS int* qw = (volatile LAS int*)(lds + 131072 + 128);
    const bool xcdq = (gridDim.x == 256);
    const unsigned myx = xb_xcc_id() & 7u;
    bool bdone = !xcdq;
#define ATT_FETCH(dst_) do { int r_ = -1; \
        if (!bdone) { const unsigned j_ = atomicAdd(P.xq + 8 * myx, 1u); \
            if (j_ < 64u) { const unsigned gi_ = myx + 8u * (j_ >> 5), r2_ = j_ & 31u; r_ = (int)((gi_ >> 1) * 64u + ((gi_ & 1u) * 4u + (r2_ >> 3)) * 8u + (r2_ & 7u)); } else bdone = true; } \
        if (r_ < 0) r_ = (xcdq ? 512 : 0) + (int)atomicAdd(P.counter, 1u); \
        dst_ = r_; } while (0)
    int nxt = 0;
    if (threadIdx.x == 0) ATT_FETCH(nxt);
    for (;;) {
        if (threadIdx.x == 0) qw[0] = nxt;
        __syncthreads();
        const int u = qw[0];
        if (u >= P.nunits) break;
        if (threadIdx.x == 0) ATT_FETCH(nxt);
        int mode, b, qhead, kvh, qpos0 = 0, qrow0, tlo = 0, thi = 0, sinkidx = -1;
        if (u < 512) { mode = 0; b = u >> 6; const int g = (u >> 3) & 7, qb = u & 7; qhead = 4 + g; kvh = 4 + (g >> 2); qpos0 = qb * 256; qrow0 = b * SEQ + qpos0; tlo = 0; thi = 32; }
        else if (u < 768) { const int v = u - 512; mode = 1; b = v >> 5; const int h = (v >> 3) & 3, qb = v & 7; qhead = h; kvh = h; qpos0 = qb * 256; qrow0 = b * SEQ + qpos0;
            const int r0 = 4 * qb; tlo = min(max(r0 - 4, 0), 24); thi = min(max(r0 - 1, 0), 24) + 8; }
        else if (u < 1024) { const int v = u - 768; mode = 2; b = v >> 5; const int h = (v >> 3) & 3, qb = v & 7; qhead = 12 + h; kvh = 6 + (h >> 1); qpos0 = qb * 256; qrow0 = b * SEQ + qpos0;
            tlo = max(0, 4 * qb - 2); thi = min(32, 4 * qb + 6); sinkidx = h; }
        else { const int v = u - 1024; mode = 3; b = v >> 4; qhead = v & 15; kvh = qhead < 4 ? qhead : (qhead < 12 ? 4 + ((qhead - 4) >> 2) : 6 + ((qhead - 12) >> 1)); qrow0 = ML + b * CTXL;
            if (qhead >= 12) sinkidx = qhead - 12; }
        if (mode == 1) attn_unit<1>(lds, P, b, qhead, kvh, qpos0, qrow0, tlo, thi, sinkidx);
        else if (mode == 2) attn_unit<2>(lds, P, b, qhead, kvh, qpos0, qrow0, tlo, thi, sinkidx);
        else if (P.bbound < 64.0f && qhead >= 4 && qhead < 12) attn_unit<0, true>(lds, P, b, qhead, kvh, qpos0, qrow0, tlo, thi, sinkidx);
        else attn_unit<0>(lds, P, b, qhead, kvh, qpos0, qrow0, tlo, thi, sinkidx);
    }
}

__global__ void __launch_bounds__(512, 2) mega_fwd(Args a) {
    extern __shared__ __attribute__((aligned(16))) unsigned char lds_raw[];
    LAS unsigned char* lds = (LAS unsigned char*)lds_raw;
    cg::grid_group grid = cg::this_grid();
    volatile LAS unsigned* bst = (volatile LAS unsigned*)(lds + 131072 + 64);
    if (threadIdx.x == 0) { bst[0] = 0u; bst[1] = 0u; }
    __syncthreads();
    const XcdBarrier xbar = xcd_barrier_post((unsigned*)(a.ws + WS_CTL) + 4096, bst);
#ifndef PH
#define PH 0xFFF
#endif
#ifndef PROBE
#define PROBE 0
#endif
#define PHASE_BEGIN() unsigned char* ws = a.ws; int G = gridDim.x, bx = blockIdx.x; asm volatile("" : "+s"(ws), "+s"(G), "+s"(bx))
    if (PH & 1) prologue(a, lds);
    if (PROBE == 5) { __syncthreads(); prologue(a, lds); }
    if (a.ws == nullptr) grid.sync();
    xcd_barrier(xbar);

    for (int l = 0; l < DEPTH; ++l) {
        const bool last = (l == DEPTH - 1);
        const int Mff = last ? ML : MT;
        if (PH & 2) { PHASE_BEGIN(); (void)G; (void)bx;
            const float* modl = (const float*)(ws + WS_MOD) + (size_t)l * 9 * NMOD; float* X = (float*)(ws + WS_X); bf16_t* H = (bf16_t*)(ws + WS_H);
            const float* cp = (const float*)(ws + WS_CP);
            if (l == 0) norm_phase(a.in[0], a.in[2], X, cp + CP_AN, modl, 0, 1024, H, MT);
            else        norm_phase(X, X + (size_t)ML * DM, nullptr, cp + CP_AN + l * DM, modl, 0, 1024, H, MT, gridDim.x == 256 ? (const bf16_t*)(ws + WS_PB) : (const bf16_t*)nullptr); }
        xcd_barrier(xbar); if (PROBE == 4) xcd_barrier(xbar);
        if (PH & 4) { PHASE_BEGIN();
          pg8::Gemm g{(bf16_t*)(ws + WS_H), (bf16_t*)(ws + WS_WIN) + (size_t)l * DPROJ * DM, MT, DPROJ, DM}; pg8::StaticOrder S; S.init(MT, DPROJ, G, bx);
          const float* cosT = (const float*)(ws + WS_ROPE);
          EpiQKV E{(bf16_t*)(ws + WS_Q), (bf16_t*)(ws + WS_K), (bf16_t*)(ws + WS_V), (const float*)(ws + WS_GAIN) + l * 128, cosT, cosT + SEQ * 32};
          pg8::gemm_phase<EpiQKV, pg8::StaticOrder, true, true>(lds, g, S, E);
          if (PROBE == 2) { xcd_barrier(xbar); pg8::gemm_phase<EpiQKV, pg8::StaticOrder, true, true>(lds, g, S, E); } }
        xcd_barrier(xbar); if (PROBE == 4) xcd_barrier(xbar);
        if (PH & 8) { PHASE_BEGIN(); (void)G; (void)bx;
          const float* cp = (const float*)(ws + WS_CP);
          AttnP P{(bf16_t*)(ws + WS_Q), (bf16_t*)(ws + WS_O), (bf16_t*)(ws + WS_K), (bf16_t*)(ws + WS_V), cp + CP_RPB + l * 4 * 465, cp + CP_SINK + l * 4, (unsigned*)(ws + WS_CTL) + 64 * l, last ? 1024 : 1152, *((const float*)(ws + WS_GAIN) + 512 + l), (unsigned*)(ws + WS_CTL) + 2048 + 64 * l};
          attn_phase(lds, P);
          if (PROBE == 1) { xcd_barrier(xbar); AttnP P2 = P; P2.counter = (unsigned*)(ws + WS_CTL) + 64 * (l + 4); attn_phase(lds, P2); } }
        xcd_barrier(xbar); if (PROBE == 4) xcd_barrier(xbar);
        if (PH & 16) { PHASE_BEGIN();
          pg8::Gemm g{(bf16_t*)(ws + WS_O), (bf16_t*)(ws + WS_WOUT) + (size_t)l * DM * DM, Mff, DM, DM}; pg8::SplitCtxOrder S; S.init(Mff, DM, G, bx);
          EpiRes E{(float*)(ws + WS_X), (l == 0 && G == 256) ? a.in[0] : (const float*)(ws + WS_X), (const float*)(ws + WS_MOD) + (size_t)l * 9 * NMOD, 2048, (bf16_t*)(ws + WS_PB)};
          pg8::gemm_phase<EpiRes, pg8::SplitCtxOrder, true, true>(lds, g, S, E); }
        xcd_barrier(xbar); if (PROBE == 4) xcd_barrier(xbar);
        if (PH & 32) { PHASE_BEGIN(); (void)G; (void)bx;
            const float* modl = (const float*)(ws + WS_MOD) + (size_t)l * 9 * NMOD; float* X = (float*)(ws + WS_X);
            const float* cp = (const float*)(ws + WS_CP);
            norm_phase(X, X + (size_t)ML * DM, nullptr, cp + CP_FN + l * DM, modl, 3072, 4096, (bf16_t*)(ws + WS_H), Mff, (last || gridDim.x != 256) ? (const bf16_t*)nullptr : (const bf16_t*)(ws + WS_PB)); }
        xcd_barrier(xbar); if (PROBE == 4) xcd_barrier(xbar);
        if (PH & 64) { PHASE_BEGIN();
          pg8::Gemm g{(bf16_t*)(ws + WS_H), (bf16_t*)(ws + WS_WUP) + (size_t)l * 2 * DFF * DM, Mff, 2 * DFF, DM}; pg8::StaticOrder S; S.init(Mff, 2 * DFF, G, bx);
          const float* cp = (const float*)(ws + WS_CP) + CP_CONV;
          EpiUp E{(bf16_t*)(ws + WS_HID), (float*)(ws + WS_EDGE), cp + (size_t)l * 4 * DFF, cp + (size_t)l * 4 * DFF + 3 * DFF};
          pg8::gemm_phase<EpiUp, pg8::StaticOrder, true, true>(lds, g, S, E);
          if (PROBE == 3) { xcd_barrier(xbar); pg8::gemm_phase<EpiUp, pg8::StaticOrder, true, true>(lds, g, S, E); } }
        xcd_barrier(xbar); if (PROBE == 4) xcd_barrier(xbar);
        if (PH & 256) { PHASE_BEGIN();
          pg8::Gemm g{(bf16_t*)(ws + WS_HID), (bf16_t*)(ws + WS_WDN) + (size_t)l * DM * DFF, Mff, DM, DFF}; pg8::SplitCtxOrder S; S.init(Mff, DFF, G, bx);
          EpiRes E{(float*)(ws + WS_X), (const float*)(ws + WS_X), (const float*)(ws + WS_MOD) + (size_t)l * 9 * NMOD, 5120, (bf16_t*)(ws + WS_PB)};
          { const float* cpc = (const float*)(ws + WS_CP) + CP_CONV + (size_t)l * 4 * DFF; pg8::Unit fu;
            for (int i = 0; S.next(i, fu); ++i) fixup_tile((const float*)(ws + WS_EDGE), cpc, (bf16_t*)(ws + WS_HID), 4 * fu.pm);
            __syncthreads(); }
          pg8::gemm_phase<EpiRes, pg8::SplitCtxOrder, true, true>(lds, g, S, E); }
        xcd_barrier(xbar); if (PROBE == 4) xcd_barrier(xbar);
    }
    if (PH & 512) { PHASE_BEGIN(); (void)G; (void)bx; final_norm_phase((const float*)(ws + WS_X), (const float*)(ws + WS_CP) + CP_FIN, a.out); }
}

extern "C" void kernel_launch(void* const* d_in, const int* in_sizes, int n_in, void* d_out, int out_size, void* d_ws, size_t ws_size, hipStream_t stream) {
    static int grid = 0;
    if (grid == 0) {
        if (n_in != 19 || ws_size < WS_END) { fprintf(stderr, "kernel_launch: unexpected n_in %d or ws_size %zu (< %zu)\n", n_in, ws_size, (size_t)WS_END); grid = -1; return; }
        int dev = 0, cus = 0, per_cu = 0;
        (void)hipGetDevice(&dev);
        (void)hipDeviceGetAttribute(&cus, hipDeviceAttributeMultiprocessorCount, dev);
        if (hipFuncSetAttribute((const void*)mega_fwd, hipFuncAttributeMaxDynamicSharedMemorySize, LDS_BYTES) != hipSuccess) fprintf(stderr, "kernel_launch: hipFuncSetAttribute failed\n");
        if (hipOccupancyMaxActiveBlocksPerMultiprocessor(&per_cu, (const void*)mega_fwd, 512, LDS_BYTES) != hipSuccess || per_cu < 1) { fprintf(stderr, "kernel_launch: occupancy query says %d\n", per_cu); per_cu = 1; }
        (void)hipGetLastError();
        grid = cus * per_cu;
        fprintf(stderr, "kernel_launch: grid %d (cus %d x %d)\n", grid, cus, per_cu);
    }
    if (grid < 0) return;
    (void)hipMemsetAsync(d_ws, 0, 65536, stream);
    Args a{};
    for (int i = 0; i < 19; ++i) a.in[i] = (const float*)d_in[i];
    a.out = (float*)d_out; a.ws = (unsigned char*)d_ws;
    void* args[] = {&a};
    hipError_t e = hipLaunchCooperativeKernel((const void*)mega_fwd, dim3(grid), dim3(512), args, LDS_BYTES, stream);
    if (e != hipSuccess) fprintf(stderr, "kernel_launch: cooperative launch failed: %s (grid %d)\n", hipGetErrorString(e), grid);
}
```

```cpp
#include <hip/hip_runtime.h>
#include <hip/hip_cooperative_groups.h>
#include <cstdio>
#include <cstdint>
namespace cg = cooperative_groups;
namespace pg8 {
#define PG8_LAS __attribute__((address_space(3)))
typedef unsigned short bf16_t;
typedef short bf16x8 __attribute__((ext_vector_type(8)));
typedef float f32x4 __attribute__((ext_vector_type(4)));
typedef unsigned u32x4 __attribute__((ext_vector_type(4)));
constexpr int BM = 256, BK = 64, HALF = 128, HTB = HALF * BK * 2  , STAGE_BYTES = 8 * HTB, NXCD = 8, WGM = 8;

__host__ __device__ __forceinline__ int lds_byte(int r, int c) { const int st = (r >> 4) * 2 + (c >> 5), rr = r & 15, cc = c & 31, ob = rr * 64 + cc * 2; return st * 1024 + (ob ^ (((ob >> 9) & 1) << 5)); }
__host__ __device__ __forceinline__ void stage_rc(int b, int& R, int& C) { const int st = b / 1024, sb = b % 1024, swz = sb ^ (((sb >> 9) & 1) << 5); R = (st >> 1) * 16 + swz / 64; C = (st & 1) * 32 + (swz % 64) / 2; }
__host__ __device__ __forceinline__ int perm32(int rho) { const int n = rho >> 4, i = rho & 15; return 8 * (i >> 2) + 4 * n + (i & 3); }

struct Unit { int pm, pn, kt0, nt, part; };
struct Gemm { const bf16_t* A; const bf16_t* Bt; int M, N, K; };

struct StaticOrder {
    int nM, nN, nwg, G, c, ntf;
    __host__ __device__ void init(int M, int N, int G_, int c_, int K_ = 1024) { nM = M / BM; nN = N / BM; nwg = nM * nN; G = G_; c = c_; ntf = K_ / BK; }
    __host__ __device__ bool next(int i, Unit& u) const {
        const long L = (long)i * G + c; if (L >= nwg) return false;
        int wgid = (int)L; { const int q = nwg / NXCD, r = nwg % NXCD, xcd = wgid % NXCD, off = wgid / NXCD; wgid = (xcd < r ? xcd * (q + 1) : r * (q + 1) + (xcd - r) * q) + off; }
        const int wgm = (nM % NXCD == 0) ? nM / NXCD : WGM;
        const int nig = wgm * nN, gid = wgid / nig, fm = gid * wgm, gsz = (nM - fm) < wgm ? (nM - fm) : wgm;
        u.pm = fm + ((wgid % nig) % gsz); u.pn = (wgid % nig) / gsz; u.kt0 = 0; u.nt = ntf; u.part = 0; return true;
    }
    __device__ __forceinline__ void a_ready(const Unit&) const {}
    __device__ __forceinline__ void done(const Unit&) const {}
};


struct SplitCtxOrder {
    StaticOrder lat, all; bool split; int c, ntf;
    __host__ __device__ void init(int M, int K, int G, int c_) { c = c_; ntf = K / BK; split = (G == 256) && (M > 16384); lat.init(16384, 1024, G, c_, K); all.init(M, 1024, G, c_, K); }
    __host__ __device__ bool next(int i, Unit& u) const {
        Unit a; a.pm = 0; a.pn = 0; a.kt0 = 0; a.nt = ntf; a.part = 0; bool ok;
        if (!split) { Unit t; t.pm = 0; t.pn = 0; t.kt0 = 0; t.nt = ntf; t.part = 0; ok = all.next(i, t); a = t; }
        else if (i == 0) { Unit t; t.pm = 0; t.pn = 0; t.kt0 = 0; t.nt = ntf; t.part = 0; ok = lat.next(0, t); a = t; }
        else { ok = (i == 1) && (c < 128); const int cu = c >> 2, sl = c & 3;
            a.pm = 64 + (cu >> 2); a.pn = cu & 3; a.part = 1 + sl;
            a.kt0 = ntf == 16 ? 4 * sl : (sl == 0 ? 0 : sl == 1 ? 12 : sl == 2 ? 24 : 34); a.nt = ntf == 16 ? 4 : (sl < 2 ? 12 : 10); }
        u.pm = a.pm; u.pn = a.pn; u.kt0 = a.kt0; u.nt = a.nt; u.part = a.part; return ok;
    }
    __device__ __forceinline__ void a_ready(const Unit&) const {}
    __device__ __forceinline__ void done(const Unit&) const {}
};
__device__ __forceinline__ unsigned cvt_pk_bf16(float lo, float hi) { unsigned r; asm volatile("v_cvt_pk_bf16_f32 %0, %1, %2" : "=v"(r) : "v"(lo), "v"(hi)); return r; }
template <class Epi, class Sched, bool ALIGN_EPI = false, bool SP2 = false>
__device__ __forceinline__ void gemm_phase(PG8_LAS unsigned char* lds, const Gemm g, const Sched& S, const Epi& E) {
    int tid_l = threadIdx.x; asm volatile("" : "+v"(tid_l));
    const int tid = tid_l, wid = __builtin_amdgcn_readfirstlane(tid >> 6), lane = tid & 63, wr = wid >> 2, wc = wid & 3, fr = lane & 15, fq = lane >> 4;
    const int K = g.K;
    unsigned voffA[2], voffB[2];
#pragma unroll
    for (int i = 0; i < 2; ++i) { int R, C; stage_rc(tid * 16 + i * 8192, R, C); const int Rb = Epi::PERM ? ((R & ~31) + perm32(R & 31)) : R;
        voffA[i] = (unsigned)(R * K + C) * 2u; voffB[i] = (unsigned)(Rb * K + C) * 2u; }
    const size_t kstep = (size_t)(BK * 2);
    const size_t hstep = (size_t)HALF * K * 2;
    const size_t tstep = 2 * hstep;
    const unsigned ldsw = (unsigned)wid * 1024u;
    const int aoff = lds_byte(wr * 64 + fr, fq * 8), boff = lds_byte(wc * 32 + fr, fq * 8);
#define PG8_SA(b, h) (((b) * 2 + (h)) * HTB)
#define PG8_SB(b, h) ((4 + (b) * 2 + (h)) * HTB)
#define PG8_STAGE(bufoff, gbase, voff) do { _Pragma("unroll") for (int _i = 0; _i < 2; ++_i) \
        __builtin_amdgcn_global_load_lds((const unsigned*)((const char*)(gbase) + (voff)[_i]), (PG8_LAS unsigned*)(lds + (bufoff) + ldsw + _i * 8192), 16, 0, 0); } while (0)
#define PG8_LDA(dst, b, h) do { _Pragma("unroll") for (int m = 0; m < 4; ++m) _Pragma("unroll") for (int k = 0; k < 2; ++k) dst[m][k] = *(const PG8_LAS bf16x8*)(lds + PG8_SA(b, h) + aoff + m * 2048 + k * 1024); } while (0)
#define PG8_LDB(dst, b, h) do { _Pragma("unroll") for (int n = 0; n < 2; ++n) _Pragma("unroll") for (int k = 0; k < 2; ++k) dst[n][k] = *(const PG8_LAS bf16x8*)(lds + PG8_SB(b, h) + boff + n * 2048 + k * 1024); } while (0)
#define PG8_MMA(ai, bj, At, Bt) do { __builtin_amdgcn_s_setprio(1); _Pragma("unroll") for (int m = 0; m < 4; ++m) _Pragma("unroll") for (int n = 0; n < 2; ++n) _Pragma("unroll") for (int k = 0; k < 2; ++k) \
        acc[ai][bj][m][n] = __builtin_amdgcn_mfma_f32_16x16x32_bf16(Bt[n][k], At[m][k], acc[ai][bj][m][n], 0, 0, 0); __builtin_amdgcn_s_setprio(0); } while (0)
#define PG8_WAIT_V(n) asm volatile("s_waitcnt vmcnt(" #n ")" ::: "memory")
#define PG8_WAIT_L(n) asm volatile("s_waitcnt lgkmcnt(" #n ")" ::: "memory")
#define PG8_BAR __builtin_amdgcn_s_barrier()
#define PG8_SCHED __builtin_amdgcn_sched_barrier(0)
    Unit cur, nxt; int ui = 0;
    if (!S.next(0, cur)) return;
    int nt = cur.nt;
    f32x4 acc[2][2][4][2];
#pragma unroll
    for (int a = 0; a < 2; ++a)
#pragma unroll
        for (int b = 0; b < 2; ++b)
#pragma unroll
            for (int m = 0; m < 4; ++m)
#pragma unroll
                for (int n = 0; n < 2; ++n) acc[a][b][m][n] = (f32x4){0.f, 0.f, 0.f, 0.f};
    bf16x8 At[4][2], B0[2][2], B1[2][2];
    const char* cA = (const char*)g.A + (size_t)cur.pm * tstep + (size_t)cur.kt0 * kstep; const char* cB = (const char*)g.Bt + (size_t)cur.pn * tstep + (size_t)cur.kt0 * kstep;
    S.a_ready(cur);
    if constexpr (SP2) {
        PG8_STAGE(PG8_SB(0, 0), cB, voffB); PG8_STAGE(PG8_SB(0, 1), cB + hstep, voffB); PG8_STAGE(PG8_SA(0, 0), cA, voffA); PG8_STAGE(PG8_SA(0, 1), cA + hstep, voffA);
        if (wr == 1) PG8_BAR;
        PG8_WAIT_V(2); PG8_BAR;
        PG8_STAGE(PG8_SB(1, 0), cB + kstep, voffB); PG8_STAGE(PG8_SA(1, 0), cA + kstep, voffA); PG8_STAGE(PG8_SB(1, 1), cB + hstep + kstep, voffB);
        PG8_WAIT_V(6); PG8_BAR;
    } else {
        PG8_STAGE(PG8_SB(0, 0), cB, voffB); PG8_STAGE(PG8_SA(0, 0), cA, voffA); PG8_STAGE(PG8_SB(0, 1), cB + hstep, voffB); PG8_STAGE(PG8_SA(0, 1), cA + hstep, voffA);
        if (wr == 1) PG8_BAR;
        PG8_WAIT_V(4); PG8_BAR;
        PG8_STAGE(PG8_SB(1, 0), cB + kstep, voffB); PG8_STAGE(PG8_SA(1, 0), cA + kstep, voffA); PG8_STAGE(PG8_SB(1, 1), cB + hstep + kstep, voffB);
        PG8_WAIT_V(6); PG8_BAR;
    }
    for (;;) {
        const bool has_next = S.next(ui + 1, nxt);
        const char* nA = has_next ? (const char*)g.A + (size_t)nxt.pm * tstep + (size_t)nxt.kt0 * kstep : cA; const char* nB = has_next ? (const char*)g.Bt + (size_t)nxt.pn * tstep + (size_t)nxt.kt0 * kstep : cB;
        for (int t = 0; t < nt; t += 2) {
            const bool last = (t == nt - 2);
            const char* a1 = cA + (size_t)(t + 1) * kstep;
            const char* a2 = last ? nA : cA + (size_t)(t + 2) * kstep; const char* b2 = last ? nB : cB + (size_t)(t + 2) * kstep;
            const char* a3 = a2 + kstep; const char* b3 = b2 + kstep;
            if (last && has_next) S.a_ready(nxt);
            if constexpr (SP2) {
            PG8_LDB(B0, 0, 0); PG8_LDB(B1, 0, 1); PG8_SCHED; PG8_LDA(At, 0, 0); PG8_STAGE(PG8_SA(1, 1), a1 + hstep, voffA);
            PG8_WAIT_V(8); PG8_WAIT_L(0); PG8_BAR; PG8_MMA(0, 0, At, B0); PG8_MMA(0, 1, At, B1); PG8_BAR; PG8_SCHED;
            PG8_LDA(At, 0, 1); PG8_STAGE(PG8_SB(0, 0), b2, voffB); PG8_STAGE(PG8_SB(0, 1), b2 + hstep, voffB); PG8_STAGE(PG8_SA(0, 0), a2, voffA);
            PG8_WAIT_V(8); PG8_WAIT_L(0); PG8_BAR; PG8_MMA(1, 0, At, B0); PG8_MMA(1, 1, At, B1); PG8_BAR; PG8_SCHED;
            PG8_LDB(B0, 1, 0); PG8_LDB(B1, 1, 1); PG8_SCHED; PG8_LDA(At, 1, 0); PG8_STAGE(PG8_SA(0, 1), a2 + hstep, voffA);
            PG8_WAIT_V(8); PG8_WAIT_L(0); PG8_BAR; PG8_MMA(0, 0, At, B0); PG8_MMA(0, 1, At, B1); PG8_BAR; PG8_SCHED;
            PG8_LDA(At, 1, 1); PG8_STAGE(PG8_SB(1, 0), b3, voffB); PG8_STAGE(PG8_SB(1, 1), b3 + hstep, voffB); PG8_STAGE(PG8_SA(1, 0), a3, voffA);
            PG8_WAIT_V(8); PG8_WAIT_L(0); PG8_BAR; PG8_MMA(1, 0, At, B0); PG8_MMA(1, 1, At, B1); PG8_BAR; PG8_SCHED;
            } else {
            PG8_LDB(B0, 0, 0); PG8_SCHED; PG8_LDA(At, 0, 0); PG8_STAGE(PG8_SA(1, 1), a1 + hstep, voffA);
            PG8_WAIT_L(8); PG8_BAR; PG8_WAIT_L(0); PG8_MMA(0, 0, At, B0); PG8_BAR; PG8_SCHED;
            PG8_LDB(B1, 0, 1); PG8_STAGE(PG8_SB(0, 0), b2, voffB);
            PG8_BAR; PG8_WAIT_L(0); PG8_MMA(0, 1, At, B1); PG8_BAR;
            PG8_LDA(At, 0, 1); PG8_STAGE(PG8_SA(0, 0), a2, voffA);
            PG8_BAR; PG8_WAIT_L(0); PG8_MMA(1, 0, At, B0); PG8_BAR; PG8_SCHED;
            PG8_STAGE(PG8_SB(0, 1), b2 + hstep, voffB);
            PG8_WAIT_V(6); PG8_BAR; PG8_MMA(1, 1, At, B1); PG8_BAR;
            PG8_LDB(B0, 1, 0); PG8_SCHED; PG8_LDA(At, 1, 0); PG8_STAGE(PG8_SA(0, 1), a2 + hstep, voffA);
            PG8_WAIT_L(8); PG8_BAR; PG8_WAIT_L(0); PG8_MMA(0, 0, At, B0); PG8_BAR; PG8_SCHED;
            PG8_LDB(B1, 1, 1); PG8_STAGE(PG8_SB(1, 0), b3, voffB);
            PG8_BAR; PG8_WAIT_L(0); PG8_MMA(0, 1, At, B1); PG8_BAR;
            PG8_LDA(At, 1, 1); PG8_STAGE(PG8_SA(1, 0), a3, voffA);
            PG8_BAR; PG8_WAIT_L(0); PG8_MMA(1, 0, At, B0); PG8_BAR; PG8_SCHED;
            PG8_STAGE(PG8_SB(1, 1), b3 + hstep, voffB);
            PG8_WAIT_V(6); PG8_BAR; PG8_MMA(1, 1, At, B1); PG8_BAR;
            }
        }
        if constexpr (ALIGN_EPI) { if (wr == 0) PG8_BAR; }
        if constexpr (!Epi::AFTER_DRAIN) { E(acc, cur, wr, wc, fr, fq); S.done(cur); }
        if (!has_next) break;
#pragma unroll
        for (int a = 0; a < 2; ++a)
#pragma unroll
            for (int b = 0; b < 2; ++b)
#pragma unroll
                for (int m = 0; m < 4; ++m)
#pragma unroll
                    for (int n = 0; n < 2; ++n) acc[a][b][m][n] = (f32x4){0.f, 0.f, 0.f, 0.f};
        cur = nxt; cA = nA; cB = nB; ++ui; nt = cur.nt;
        if constexpr (ALIGN_EPI) { if (wr == 1) PG8_BAR; }
    }
    PG8_WAIT_V(0);
    if constexpr (!ALIGN_EPI) { if (wr == 0) PG8_BAR; }
    PG8_BAR;
    if constexpr (Epi::AFTER_DRAIN) { E.fused(acc, cur, wr, wc, fr, fq, lds, wid, lane); S.done(cur); }
#undef PG8_SA
#undef PG8_SB
#undef PG8_STAGE
#undef PG8_LDA
#undef PG8_LDB
#undef PG8_MMA
#undef PG8_WAIT_V
#undef PG8_WAIT_L
#undef PG8_BAR
#undef PG8_SCHED
}
}

#define GAS __attribute__((address_space(1)))
#define LAS __attribute__((address_space(3)))
typedef unsigned short bf16_t;
typedef float f32x4 __attribute__((ext_vector_type(4)));
typedef float f32x16 __attribute__((ext_vector_type(16)));
typedef short bf16x8 __attribute__((ext_vector_type(8)));
typedef unsigned u32x4 __attribute__((ext_vector_type(4)));
typedef unsigned u32x2 __attribute__((ext_vector_type(2)));
using pg8::cvt_pk_bf16;

constexpr int DM = 1024, NB = 8, SEQ = 2048, CTXL = 256, DEPTH = 4;
constexpr int ML = NB * SEQ, MC = NB * CTXL, MT = ML + MC;
constexpr int DPROJ = 2048, DFF = 2816, NMOD = 6144, KT = 36;
constexpr float EPS = 1e-6f;
constexpr float LOG2E = 1.4426950408889634f;
constexpr float QSCALE = 0.125f * LOG2E;
constexpr float NEGBIG = -1e30f;

constexpr size_t MiB = 1u << 20;
constexpr size_t WS_CTL = 0, WS_WIN = 1 * MiB, WS_WOUT = 17 * MiB, WS_WUP = 25 * MiB, WS_WDN = 69 * MiB, WS_MOD = 91 * MiB, WS_ROPE = 92 * MiB,
                 WS_X = 93 * MiB, WS_H = 165 * MiB, WS_EDGE = 201 * MiB, WS_Q = 221 * MiB, WS_O = 257 * MiB, WS_K = 293 * MiB, WS_V = 311 * MiB,
                 WS_HID = 221 * MiB, WS_PB = 329 * MiB, WS_END = 345 * MiB;
constexpr size_t WS_GAIN = WS_MOD + 917504, WS_CP = WS_ROPE + 524288;
constexpr int CP_AN = 0, CP_FN = 4096, CP_RPB = 8192, CP_SINK = 15632, CP_FIN = 15648, CP_CONV = 16896;
constexpr int LDS_BYTES = 147456;

#define LDS_WAIT() asm volatile("s_waitcnt lgkmcnt(0)" ::: "memory")

#define XB_TMO      128
#define XB_XCNT(j)  (256  + 64 * (j))
#define XB_XSUB(j)  (1280 + 64 * (j))
#define XB_XGEN(j)  (2304 + 64 * (j))
#define XB_TOP      3328
#define XB_TOPGEN   3392
#define XCD_BAR_WORDS 3456
#define XB_SPIN_CAP (1u << 18)

__device__ __forceinline__ unsigned xb_ld(unsigned* p)              { return __hip_atomic_load(p, __ATOMIC_RELAXED, __HIP_MEMORY_SCOPE_AGENT); }
__device__ __forceinline__ unsigned xb_add(unsigned* p, unsigned v) { return __hip_atomic_fetch_add(p, v, __ATOMIC_RELAXED, __HIP_MEMORY_SCOPE_AGENT); }
__device__ __forceinline__ unsigned xb_xcc_id() { return (unsigned)__builtin_amdgcn_s_getreg((3 << 11) | 20) & 0xFu; }
#define XB_SPIN(cond, bar) do { unsigned _sp = 0; while (cond) { __builtin_amdgcn_s_sleep(1); \
    if ((++_sp & 255u) == 0u) { if (xb_ld(&(bar)[XB_TMO])) break; if (_sp > XB_SPIN_CAP) { atomicAdd(&(bar)[XB_TMO], 1u); break; } } } } while (0)

struct XcdBarrier {
    unsigned* bar; unsigned x;
    volatile LAS unsigned* st;
};

__device__ __forceinline__ XcdBarrier xcd_barrier_post(unsigned* bar, volatile LAS unsigned* st) {
    XcdBarrier b; b.bar = bar; b.x = xb_xcc_id(); b.st = st;
    if (threadIdx.x == 0) (void)xb_add(&bar[XB_XCNT(b.x)], 1u);
    return b;
}
__device__ __forceinline__ void xcd_barrier_complete(unsigned* bar, unsigned x, unsigned& nloc, unsigned& nx) {
    const unsigned G = gridDim.x * gridDim.y * gridDim.z;
    unsigned sum, cnt, mine, sp = 0u;
    for (;;) {
        sum = 0u; cnt = 0u; mine = 0u;
#pragma unroll
        for (unsigned j = 0; j < 16; ++j) { const unsigned c = xb_ld(&bar[XB_XCNT(j)]); sum += c; cnt += (c > 0u) ? 1u : 0u; mine = (j == x) ? c : mine; }
        if (sum == G) break;
        __builtin_amdgcn_s_sleep(1);
        if ((++sp & 255u) == 0u) { if (xb_ld(&bar[XB_TMO])) break; if (sp > XB_SPIN_CAP) { atomicAdd(&bar[XB_TMO], 1u); break; } }
    }
    nloc = mine > 0u ? mine : 1u; nx = cnt > 0u ? cnt : 1u;
}

__device__ __forceinline__ void xcd_barrier(const XcdBarrier& b) {
    asm volatile("s_waitcnt vmcnt(0)" ::: "memory");
    __syncthreads();
    if (threadIdx.x == 0) {
        unsigned* bar = b.bar;
        __builtin_amdgcn_s_waitcnt(0);
        unsigned nloc = b.st[0], nx = b.st[1];
        if (nloc == 0u) { xcd_barrier_complete(bar, b.x, nloc, nx); b.st[0] = nloc; b.st[1] = nx; }
        const unsigned old = xb_add(&bar[XB_XSUB(b.x)], 1u);
        const unsigned gen = old / nloc;
        if (old + 1u == (gen + 1u) * nloc) {
            __builtin_amdgcn_fence(__ATOMIC_RELEASE, "agent");
            asm volatile("s_waitcnt vmcnt(0)" ::: "memory");
            const unsigned og = xb_add(&bar[XB_TOP], 1u);
            const unsigned tg = og / nx;
            if (og + 1u == (tg + 1u) * nx) xb_add(&bar[XB_TOPGEN], 1u);
            else XB_SPIN(xb_ld(&bar[XB_TOPGEN]) == tg, bar);
            __builtin_amdgcn_fence(__ATOMIC_ACQUIRE, "agent");
            xb_add(&bar[XB_XGEN(b.x)], 1u);
            asm volatile("s_waitcnt vmcnt(0)" ::: "memory");
        } else {
            XB_SPIN(xb_ld(&bar[XB_XGEN(b.x)]) == gen, bar);
            __builtin_amdgcn_fence(__ATOMIC_ACQUIRE, "agent");
            asm volatile("s_waitcnt vmcnt(0)" ::: "memory");
        }
    }
    __syncthreads();
}

struct Args { const float* in[19]; float* out; unsigned char* ws; };

__device__ __forceinline__ float wave_sum(float v) {
#pragma unroll
    for (int o = 1; o < 64; o <<= 1) v += __shfl_xor(v, o);
    return v;
}
__device__ __forceinline__ float silu_f(float x) { return x * __builtin_amdgcn_rcpf(1.0f + __builtin_amdgcn_exp2f(-x * LOG2E)); }
__device__ __forceinline__ float dpp_ror1(float x)  { return __builtin_bit_cast(float, __builtin_amdgcn_update_dpp(0, __builtin_bit_cast(int, x), 0x121, 0xf, 0xf, false)); }
__device__ __forceinline__ float dpp_ror15(float x) { return __builtin_bit_cast(float, __builtin_amdgcn_update_dpp(0, __builtin_bit_cast(int, x), 0x12F, 0xf, 0xf, false)); }

__device__ __forceinline__ void tr_item(const float* W, int K, int N, bf16_t* WT, int k0, int src_n0, int dst_n0, LAS float* scr, int lane) {
#pragma unroll 8
    for (int i = 0; i < 32; ++i) { const int kk = 2 * i + (lane >> 5); scr[kk * 33 + (lane & 31)] = W[(size_t)(k0 + kk) * N + src_n0 + (lane & 31)]; }
    LDS_WAIT(); asm volatile("" ::: "memory");
    const int c = lane & 7;
#pragma unroll
    for (int j = 0; j < 4; ++j) { const int n = (lane >> 3) + 8 * j; const LAS float* s = scr + (8 * c) * 33 + n;
        u32x4 o; o.x = cvt_pk_bf16(s[0 * 33], s[1 * 33]); o.y = cvt_pk_bf16(s[2 * 33], s[3 * 33]); o.z = cvt_pk_bf16(s[4 * 33], s[5 * 33]); o.w = cvt_pk_bf16(s[6 * 33], s[7 * 33]);
        *(u32x4*)(WT + (size_t)(dst_n0 + n) * K + k0 + 8 * c) = o; }
    LDS_WAIT(); asm volatile("" ::: "memory");
}

__device__ __forceinline__ void prologue(const Args& a, LAS unsigned char* lds) {
    const int tid = threadIdx.x, lane = tid & 63, wave = tid >> 6;
    unsigned char* ws = a.ws;
    {
        LAS float* scr = (LAS float*)(lds + 49152 + wave * 8704);
        const int gw = blockIdx.x * 8 + wave, NGW = gridDim.x * 8;
        constexpr int I_IN = 16 * 64, I_OUT = 16 * 32, I_UP = 16 * 176, I_DN = 44 * 32, I_L = I_IN + I_OUT + I_UP + I_DN;
        for (int it = gw; it < DEPTH * I_L; it += NGW) {
            const int l = it / I_L; int r = it % I_L;
            if (r < I_IN) { const int kb = r / 64, nb = r % 64, pn = nb >> 3, p0 = (nb & 7) * 32;
                const int src = 256 * pn + 64 * ((p0 & 127) >> 5) + 32 * (p0 >> 7);
                tr_item(a.in[8] + (size_t)l * DM * DPROJ, DM, DPROJ, (bf16_t*)(ws + WS_WIN) + (size_t)l * DPROJ * DM, kb * 64, src, nb * 32, scr, lane); continue; }
            r -= I_IN;
            if (r < I_OUT) { const int kb = r / 32, nb = r % 32;
                tr_item(a.in[13] + (size_t)l * DM * DM, DM, DM, (bf16_t*)(ws + WS_WOUT) + (size_t)l * DM * DM, kb * 64, nb * 32, nb * 32, scr, lane); continue; }
            r -= I_OUT;
            if (r < I_UP) { const int kb = r / 176, nb = r % 176, pn = nb >> 3, p0 = (nb & 7) * 32;
                const int src = p0 < 128 ? 128 * pn + p0 : DFF + 128 * pn + p0 - 128;
                tr_item(a.in[14] + (size_t)l * DM * 2 * DFF, DM, 2 * DFF, (bf16_t*)(ws + WS_WUP) + (size_t)l * 2 * DFF * DM, kb * 64, src, nb * 32, scr, lane); continue; }
            r -= I_UP;
            { const int kb = r / 32, nb = r % 32;
                tr_item(a.in[17] + (size_t)l * DFF * DM, DFF, DM, (bf16_t*)(ws + WS_WDN) + (size_t)l * DM * DFF, kb * 64, nb * 32, nb * 32, scr, lane); }
        }
    }
    {
        float* cosT = (float*)(ws + WS_ROPE); float* sinT = cosT + SEQ * 32;
        for (int idx = blockIdx.x * 512 + tid; idx < SEQ * 32; idx += gridDim.x * 512) {
            const int t = idx >> 5, i = idx & 31, p = i & 15, pa = p >> 2, pb = p & 3;
            const int pos = i < 16 ? (t >> 6) : (t & 63);
            const double ia = pa == 0 ? 1.0 : pa == 1 ? 0.1 : pa == 2 ? 0.01 : 0.001;
            const double ib = pb == 0 ? 1.0 : pb == 1 ? 0.5623413251903491 : pb == 2 ? 0.31622776601683794 : 0.17782794100389228;
            const double x = (double)pos * (ia * ib);
            const double kq = __builtin_rint(x * 0.6366197723675814);
            const double r = (x - kq * 1.5707963267948966) - kq * 6.123233995736766e-17;
            const double r2 = r * r;
            const double sn = r * (1.0 + r2 * (-1.0 / 6 + r2 * (1.0 / 120 + r2 * (-1.0 / 5040 + r2 * (1.0 / 362880 + r2 * (-1.0 / 39916800 + r2 * (1.0 / 6227020800.0)))))));
            const double cs = 1.0 + r2 * (-0.5 + r2 * (1.0 / 24 + r2 * (-1.0 / 720 + r2 * (1.0 / 40320 + r2 * (-1.0 / 3628800 + r2 * (1.0 / 479001600 + r2 * (-1.0 / 87178291200.0)))))));
            const int q = ((int)kq) & 3;
            const double c = q == 0 ? cs : q == 1 ? -sn : q == 2 ? -cs : sn;
            const double s = q == 0 ? sn : q == 1 ? cs : q == 2 ? -sn : -cs;
            cosT[idx] = (float)c; sinT[idx] = (float)s;
        }
    }
    if (blockIdx.x == 0) { float* gains = (float*)(ws + WS_GAIN); const int l = tid >> 7, w = (tid >> 6) & 1, d = tid & 63; gains[tid] = w ? a.in[10][l * 64 + d] : a.in[9][l * 64 + d];
        if (tid < DEPTH) { float mq = 0.f, mk = 0.f; for (int d2 = 0; d2 < 64; ++d2) { mq = fmaxf(mq, fabsf(a.in[9][tid * 64 + d2])); mk = fmaxf(mk, fabsf(a.in[10][tid * 64 + d2])); }
            gains[512 + tid] = 64.0f * mq * mk * QSCALE * 1.02f; } }
    { float* cp = (float*)(ws + WS_CP); const int gt = blockIdx.x * 512 + tid, NT = gridDim.x * 512;
      for (int i = gt; i < 4096; i += NT) { cp[CP_AN + i] = a.in[4][i]; cp[CP_FN + i] = a.in[5][i]; }
      for (int i = gt; i < 7440; i += NT) cp[CP_RPB + i] = a.in[11][i];
      for (int i = gt; i < 16; i += NT) cp[CP_SINK + i] = a.in[12][i];
      for (int i = gt; i < 1024; i += NT) cp[CP_FIN + i] = a.in[18][i];
      for (int i = gt; i < DEPTH * 4 * DFF; i += NT) { const int l = i / (4 * DFF), r = i % (4 * DFF); cp[CP_CONV + i] = r < 3 * DFF ? a.in[15][l * 3 * DFF + r] : a.in[16][l * DFF + r - 3 * DFF]; } }
    {
        LAS float* ca = (LAS float*)lds;
        LAS float* red = (LAS float*)(lds + 36864);
        for (int idx = tid; idx < 9 * DM; idx += 512) { const int r = idx >> 10, k = idx & 1023; const float v = r < 8 ? a.in[1][r * DM + k] : a.in[3][k]; ca[idx] = v / (1.0f + expf(-v)); }
        __syncthreads();
        float* mod = (float*)(ws + WS_MOD);
        const int c4 = lane & 7, kr = lane >> 3;
        for (int item = blockIdx.x; item < DEPTH * 192; item += gridDim.x) {
            const int l = item / 192, col0 = (item % 192) * 32;
            f32x4 acc[9];
#pragma unroll
            for (int r = 0; r < 9; ++r) acc[r] = (f32x4){0.f, 0.f, 0.f, 0.f};
            const float* wp = a.in[6] + ((size_t)l * DM + wave * 128 + kr) * NMOD + col0 + 4 * c4;
#pragma unroll 4
            for (int i = 0; i < 16; ++i) { const f32x4 wv = *(const f32x4*)(wp + (size_t)i * 8 * NMOD); const int k = wave * 128 + 8 * i + kr;
#pragma unroll
                for (int r = 0; r < 9; ++r) acc[r] += ca[r * DM + k] * wv; }
#pragma unroll
            for (int r = 0; r < 9; ++r)
#pragma unroll
                for (int j = 0; j < 4; ++j) { float v = acc[r][j]; v += __shfl_xor(v, 8); v += __shfl_xor(v, 16); v += __shfl_xor(v, 32); acc[r][j] = v; }
            if (kr == 0) {
#pragma unroll
                for (int r = 0; r < 9; ++r) *(LAS f32x4*)(red + (wave * 9 + r) * 32 + 4 * c4) = acc[r]; }
            __syncthreads();
            if (tid < 288) { const int r = tid >> 5, ci = tid & 31; float s = a.in[7][l * NMOD + col0 + ci];
#pragma unroll
                for (int w = 0; w < 8; ++w) s += red[(w * 9 + r) * 32 + ci];
                mod[((size_t)l * 9 + r) * NMOD + col0 + ci] = s; }
            __syncthreads();
        }
    }
}

__device__ __forceinline__ void norm_phase(const float* srcL, const float* srcC, float* xcopy, const float* g, const float* modl, int shoff, int scoff, bf16_t* H, int nrows, const bf16_t* PB = nullptr) {
    int tid_l = threadIdx.x; asm volatile("" : "+v"(tid_l));
    const int lane = tid_l & 63, wave = tid_l >> 6;
    const int gw = blockIdx.x * 8 + wave, NGW = gridDim.x * 8;
    for (int row = gw; row < nrows; row += NGW) {
        const float* src = row < ML ? srcL + (size_t)row * DM : srcC + (size_t)(row - ML) * DM;
        const int bidx = row < ML ? row >> 11 : 8;
        const float* mr = modl + (size_t)bidx * NMOD;
        f32x4 v[4]; float ss = 0.f;
#pragma unroll
        for (int j = 0; j < 4; ++j) { v[j] = *(const f32x4*)(src + 4 * (64 * j + lane));
            if (PB && row >= ML) { const size_t o = (size_t)(row - ML) * DM + 4 * (64 * j + lane);
#pragma unroll
                for (int sl = 0; sl < 4; ++sl) { const u32x2 w = *(const u32x2*)(PB + (size_t)sl * MC * DM + o);
                    v[j].x += __uint_as_float(w.x << 16); v[j].y += __uint_as_float(w.x & 0xffff0000u); v[j].z += __uint_as_float(w.y << 16); v[j].w += __uint_as_float(w.y & 0xffff0000u); }
                *(f32x4*)(const_cast<float*>(src) + 4 * (64 * j + lane)) = v[j]; }
            ss += (v[j].x * v[j].x + v[j].y * v[j].y) + (v[j].z * v[j].z + v[j].w * v[j].w); }
        const float rstd = 1.0f / sqrtf(wave_sum(ss) * (1.0f / DM) + EPS);
#pragma unroll
        for (int j = 0; j < 4; ++j) { const int c = 4 * (64 * j + lane);
            const f32x4 gv = *(const f32x4*)(g + c), sc = *(const f32x4*)(mr + scoff + c), sh = *(const f32x4*)(mr + shoff + c);
            const f32x4 y = (v[j] * rstd) * gv * (1.0f + sc) + sh;
            u32x2 o; o.x = cvt_pk_bf16(y.x, y.y); o.y = cvt_pk_bf16(y.z, y.w);
            *(u32x2*)(H + (size_t)row * DM + c) = o;
            if (xcopy && (row >= ML || gridDim.x != 256)) *(f32x4*)(xcopy + (size_t)row * DM + c) = v[j]; }
    }
}
__device__ __forceinline__ void final_norm_phase(const float* X, const float* g, float* out) {
    const int lane = threadIdx.x & 63, wave = threadIdx.x >> 6;
    const int gw = blockIdx.x * 8 + wave, NGW = gridDim.x * 8;
    for (int row = gw; row < ML; row += NGW) {
        const float* src = X + (size_t)row * DM;
        f32x4 v[4]; float ss = 0.f;
#pragma unroll
        for (int j = 0; j < 4; ++j) { v[j] = *(const f32x4*)(src + 4 * (64 * j + lane)); ss += (v[j].x * v[j].x + v[j].y * v[j].y) + (v[j].z * v[j].z + v[j].w * v[j].w); }
        const float rstd = 1.0f / sqrtf(wave_sum(ss) * (1.0f / DM) + EPS);
#pragma unroll
        for (int j = 0; j < 4; ++j) { const int c = 4 * (64 * j + lane); const f32x4 gv = *(const f32x4*)(g + c);
            *(f32x4*)(out + (size_t)row * DM + c) = (v[j] * rstd) * gv; }
    }
}

struct EpiQKV {
    static constexpr bool PERM = true, AFTER_DRAIN = false;
    bf16_t* Q; bf16_t* Kf; bf16_t* Vf; const float* gains; const float* cosT; const float* sinT;
    __device__ __forceinline__ void operator()(const pg8::f32x4 (&acc)[2][2][4][2], const pg8::Unit& u, int wr_, int wc_, int fr_, int fq_) const {
        int wr = wr_, wc = wc_, fr = fr_, fq = fq_; asm volatile("" : "+s"(wr), "+s"(wc), "+v"(fr), "+v"(fq));
        const int pn = u.pn, pm = u.pm;
        int kind = 0, head = 0, nrm = 0, rope = 0;
        if (pn == 0) { kind = 0; head = wc; }
        else if (pn == 1) { kind = 1; head = wc; }
        else if (pn == 2) { kind = 2; head = wc; }
        else if (pn == 3 || pn == 4) { kind = 0; head = 4 * (pn - 2) + wc; nrm = 1; rope = 1; }
        else if (pn == 5) { if (wc < 2) { kind = 1; head = 4 + wc; nrm = 2; rope = 1; } else { kind = 2; head = 2 + wc; } }
        else if (pn == 6) { kind = 0; head = 12 + wc; rope = 1; }
        else { if (wc < 2) { kind = 1; head = 6 + wc; rope = 1; } else { kind = 2; head = 4 + wc; } }
        const bool latent = pm < 64;
        const int b = latent ? (pm >> 3) : (pm - 64);
        const int tile0 = latent ? (pm & 7) * 4 : 32;
        const int s0 = latent ? (pm & 7) * 256 : 0;
        if (!latent) rope = 0;
        const float* gp = gains + (nrm == 2 ? 64 : 0) + 8 * fq;
#pragma unroll
        for (int ai = 0; ai < 2; ++ai)
#pragma unroll
            for (int m = 0; m < 4; ++m) {
                const int rl = 128 * ai + 64 * wr + 16 * m + fr;
                f32x4 v[2][2];
#pragma unroll
                for (int bj = 0; bj < 2; ++bj)
#pragma unroll
                    for (int n = 0; n < 2; ++n) v[bj][n] = acc[ai][bj][m][n];
                if (nrm) {
                    float ss = 0.f;
#pragma unroll
                    for (int bj = 0; bj < 2; ++bj)
#pragma unroll
                        for (int n = 0; n < 2; ++n) ss += (v[bj][n].x * v[bj][n].x + v[bj][n].y * v[bj][n].y) + (v[bj][n].z * v[bj][n].z + v[bj][n].w * v[bj][n].w);
                    ss += __shfl_xor(ss, 16); ss += __shfl_xor(ss, 32);
                    const float rs = 1.0f / sqrtf(ss * (1.0f / 64.0f) + EPS);
#pragma unroll
                    for (int bj = 0; bj < 2; ++bj)
#pragma unroll
                        for (int n = 0; n < 2; ++n) v[bj][n] = (v[bj][n] * rs) * *(const f32x4*)(gp + 32 * bj + 4 * n);
                }
                if (rope) {
                    const int s = s0 + rl;
#pragma unroll
                    for (int n = 0; n < 2; ++n) {
                        const f32x4 cs = *(const f32x4*)(cosT + s * 32 + 8 * fq + 4 * n), sn = *(const f32x4*)(sinT + s * 32 + 8 * fq + 4 * n);
                        const f32x4 x1 = v[0][n], x2 = v[1][n];
                        v[0][n] = x1 * cs - x2 * sn; v[1][n] = x1 * sn + x2 * cs; }
                }
                if (kind == 0) {
#pragma unroll
                    for (int bj = 0; bj < 2; ++bj) { const f32x4 a0 = v[bj][0] * QSCALE, a1 = v[bj][1] * QSCALE;
                        u32x4 w; w.x = cvt_pk_bf16(a0.x, a0.y); w.y = cvt_pk_bf16(a0.z, a0.w); w.z = cvt_pk_bf16(a1.x, a1.y); w.w = cvt_pk_bf16(a1.z, a1.w);
                        *(u32x4*)(Q + (size_t)(pm * 256 + rl) * DM + head * 64 + bj * 32 + 8 * fq) = w; }
                } else if (kind == 1) {
                    bf16_t* base = Kf + ((size_t)((b * 8 + head) * KT + tile0 + 2 * ai + wr)) * 4096;
                    const int kblk = m >> 1, r32 = 16 * (m & 1) + fr;
#pragma unroll
                    for (int bj = 0; bj < 2; ++bj) { const int d0 = 2 * bj + (fq >> 1), hi = fq & 1;
                        u32x4 w; w.x = cvt_pk_bf16(v[bj][0].x, v[bj][0].y); w.y = cvt_pk_bf16(v[bj][0].z, v[bj][0].w); w.z = cvt_pk_bf16(v[bj][1].x, v[bj][1].y); w.w = cvt_pk_bf16(v[bj][1].z, v[bj][1].w);
                        *(u32x4*)(base + ((kblk * 4 + d0) * 64 + hi * 32 + r32) * 8) = w; }
                } else {
                    bf16_t* base = Vf + ((size_t)((b * 8 + head) * KT + tile0 + 2 * ai + wr)) * 4096;
#pragma unroll
                    for (int bj = 0; bj < 2; ++bj) {
                        u32x4 w; w.x = cvt_pk_bf16(v[bj][0].x, v[bj][0].y); w.y = cvt_pk_bf16(v[bj][0].z, v[bj][0].w); w.z = cvt_pk_bf16(v[bj][1].x, v[bj][1].y); w.w = cvt_pk_bf16(v[bj][1].z, v[bj][1].w);
                        *(u32x4*)(base + ((4 * m + (fr >> 2)) * 4 + 2 * bj + (fq >> 1)) * 64 + (fr & 3) * 16 + (fq & 1) * 8) = w; }
                }
                if (m & 1) asm volatile("" ::: "memory");
            }
    }
};

struct EpiRes {
    static constexpr bool PERM = false, AFTER_DRAIN = false;
    float* X; const float* Xin; const float* modl; int goff; bf16_t* PB;
    __device__ __forceinline__ void operator()(const pg8::f32x4 (&acc)[2][2][4][2], const pg8::Unit& u, int wr_, int wc_, int fr_, int fq_) const {
        int wr = wr_, wc = wc_, fr = fr_, fq = fq_; asm volatile("" : "+s"(wr), "+s"(wc), "+v"(fr), "+v"(fq));
        const int bidx = u.pm < 64 ? (u.pm >> 3) : 8;
        const float* gate = modl + (size_t)bidx * NMOD + goff;
        const int c0 = u.pn * 256 + wc * 32 + 4 * fq;
        f32x4 gv[2][2];
#pragma unroll
        for (int bj = 0; bj < 2; ++bj)
#pragma unroll
            for (int n = 0; n < 2; ++n) gv[bj][n] = *(const f32x4*)(gate + c0 + 128 * bj + 16 * n);
        if (u.part) {
            bf16_t* pb = PB + (size_t)(u.part - 1) * MC * DM;
#pragma unroll
            for (int ai = 0; ai < 2; ++ai)
#pragma unroll
                for (int m = 0; m < 4; ++m) { bf16_t* pr = pb + (size_t)((u.pm - 64) * 256 + 128 * ai + 64 * wr + 16 * m + fr) * DM + c0;
#pragma unroll
                    for (int bj = 0; bj < 2; ++bj)
#pragma unroll
                        for (int n = 0; n < 2; ++n) { const f32x4 v = gv[bj][n] * acc[ai][bj][m][n]; u32x2 o; o.x = cvt_pk_bf16(v.x, v.y); o.y = cvt_pk_bf16(v.z, v.w); *(u32x2*)(pr + 128 * bj + 16 * n) = o; } }
            return;
        }
#pragma unroll
        for (int ai = 0; ai < 2; ++ai)
#pragma unroll
            for (int m = 0; m < 4; ++m) { const size_t ro = (size_t)(u.pm * 256 + 128 * ai + 64 * wr + 16 * m + fr) * DM + c0; float* xr = X + ro; const float* xi = Xin + ro;
#pragma unroll
                for (int bj = 0; bj < 2; ++bj)
#pragma unroll
                    for (int n = 0; n < 2; ++n) { *(f32x4*)(xr + 128 * bj + 16 * n) = *(const f32x4*)(xi + 128 * bj + 16 * n) + gv[bj][n] * acc[ai][bj][m][n]; }
                if (m & 1) asm volatile("" ::: "memory"); }

    }
};

struct EpiUp {
    static constexpr bool PERM = true, AFTER_DRAIN = false;
    bf16_t* HID; float* EDGE; const float* cw; const float* cb;
    __device__ __forceinline__ void operator()(const pg8::f32x4 (&acc)[2][2][4][2], const pg8::Unit& u, int wr_, int wc_, int fr_, int fq_) const {
        int wr = wr_, wc = wc_, fr = fr_, fq = fq_; asm volatile("" : "+s"(wr), "+s"(wc), "+v"(fr), "+v"(fq));
        const int col0 = 128 * u.pn + 32 * wc + 8 * fq;
        f32x4 w0[2], w1[2], w2[2], bb[2];
#pragma unroll
        for (int n = 0; n < 2; ++n) { w0[n] = *(const f32x4*)(cw + col0 + 4 * n); w1[n] = *(const f32x4*)(cw + DFF + col0 + 4 * n); w2[n] = *(const f32x4*)(cw + 2 * DFF + col0 + 4 * n); bb[n] = *(const f32x4*)(cb + col0 + 4 * n); }
#pragma unroll
        for (int ai = 0; ai < 2; ++ai) {
            const int g = u.pm * 4 + 2 * ai + wr;
#pragma unroll
            for (int m = 0; m < 4; ++m) {
                const int row = u.pm * 256 + 128 * ai + 64 * wr + 16 * m + fr;
                f32x4 cv[2];
#pragma unroll
                for (int n = 0; n < 2; ++n) {
                    const f32x4 av = acc[ai][0][m][n];
                    f32x4 pv, nv;
#pragma unroll
                    for (int j = 0; j < 4; ++j) {
                        const float p1 = dpp_ror1(av[j]); const float p2 = m > 0 ? dpp_ror1(acc[ai][0][m > 0 ? m - 1 : 0][n][j]) : 0.f;
                        pv[j] = fr == 0 ? p2 : p1;
                        const float n1 = dpp_ror15(av[j]); const float n2 = m < 3 ? dpp_ror15(acc[ai][0][m < 3 ? m + 1 : 3][n][j]) : 0.f;
                        nv[j] = fr == 15 ? n2 : n1; }
                    cv[n] = w1[n] * av + bb[n] + w0[n] * pv + w2[n] * nv;
                }
                const bool first = (m == 0 && fr == 0), lastr = (m == 3 && fr == 15);
                if (first || lastr) {
                    float* e = EDGE + ((size_t)(g * 2 + (lastr ? 1 : 0)) * 3) * DFF + col0;
#pragma unroll
                    for (int n = 0; n < 2; ++n) { *(f32x4*)(e + 4 * n) = acc[ai][0][m][n]; *(f32x4*)(e + DFF + 4 * n) = cv[n]; *(f32x4*)(e + 2 * DFF + 4 * n) = acc[ai][1][m][n]; }
                } else {
                    f32x4 h0, h1;
#pragma unroll
                    for (int j = 0; j < 4; ++j) { h0[j] = silu_f(cv[0][j]) * acc[ai][1][m][0][j]; h1[j] = silu_f(cv[1][j]) * acc[ai][1][m][1][j]; }
                    u32x4 w; w.x = cvt_pk_bf16(h0.x, h0.y); w.y = cvt_pk_bf16(h0.z, h0.w); w.z = cvt_pk_bf16(h1.x, h1.y); w.w = cvt_pk_bf16(h1.z, h1.w);
                    __builtin_nontemporal_store(w, (u32x4*)(HID + (size_t)row * DFF + col0));
                }
            }
        }
    }
};

__device__ __forceinline__ void fixup_phase(const float* EDGE, const float* cw, bf16_t* HID, int ngroups) {
    const int total = ngroups * 2 * (DFF / 4);
    for (int idx = blockIdx.x * 512 + threadIdx.x; idx < total; idx += gridDim.x * 512) {
        const int c4 = idx % (DFF / 4), gw = idx / (DFF / 4), which = gw & 1, g = gw >> 1, col = 4 * c4;
        const int seqg = g < 256 ? 32 : 4;
        const float* e = EDGE + ((size_t)(g * 2 + which) * 3) * DFF + col;
        f32x4 part = *(const f32x4*)(e + DFF); const f32x4 bv = *(const f32x4*)(e + 2 * DFF);
        if (which == 0) { if (g % seqg != 0) part += *(const f32x4*)(cw + col) * *(const f32x4*)(EDGE + ((size_t)((g - 1) * 2 + 1) * 3) * DFF + col); }
        else { if ((g + 1) % seqg != 0) part += *(const f32x4*)(cw + 2 * DFF + col) * *(const f32x4*)(EDGE + ((size_t)((g + 1) * 2) * 3) * DFF + col); }
        u32x2 o; o.x = cvt_pk_bf16(silu_f(part.x) * bv.x, silu_f(part.y) * bv.y); o.y = cvt_pk_bf16(silu_f(part.z) * bv.z, silu_f(part.w) * bv.w);
        *(u32x2*)(HID + (size_t)(64 * g + (which ? 63 : 0)) * DFF + col) = o;
    }
}

__device__ __forceinline__ void fixup_tile(const float* EDGE, const float* cw, bf16_t* HID, int g0) {
    for (int idx = threadIdx.x; idx < 4 * 2 * (DFF / 4); idx += 512) {
        const int c4 = idx % (DFF / 4), gw = idx / (DFF / 4), which = gw & 1, g = g0 + (gw >> 1), col = 4 * c4;
        const int seqg = g < 256 ? 32 : 4;
        const float* e = EDGE + ((size_t)(g * 2 + which) * 3) * DFF + col;
        f32x4 part = *(const f32x4*)(e + DFF); const f32x4 bv = *(const f32x4*)(e + 2 * DFF);
        if (which == 0) { if (g % seqg != 0) part += *(const f32x4*)(cw + col) * *(const f32x4*)(EDGE + ((size_t)((g - 1) * 2 + 1) * 3) * DFF + col); }
        else { if ((g + 1) % seqg != 0) part += *(const f32x4*)(cw + 2 * DFF + col) * *(const f32x4*)(EDGE + ((size_t)((g + 1) * 2) * 3) * DFF + col); }
        u32x2 o; o.x = cvt_pk_bf16(silu_f(part.x) * bv.x, silu_f(part.y) * bv.y); o.y = cvt_pk_bf16(silu_f(part.z) * bv.z, silu_f(part.w) * bv.w);
        *(u32x2*)(HID + (size_t)(64 * g + (which ? 63 : 0)) * DFF + col) = o;
    }
}

struct AttnP { const bf16_t* Q; bf16_t* O; const bf16_t* Kf; const bf16_t* Vf; const float* rpb; const float* sink; unsigned* counter; int nunits; float bbound; unsigned* xq; };

typedef short v4i16_t __attribute__((ext_vector_type(4)));
typedef float f32x2 __attribute__((ext_vector_type(2)));
__device__ __forceinline__ float half_max(float m) { auto rr = __builtin_amdgcn_permlane32_swap(__float_as_uint(m), __float_as_uint(m), false, false); return fmaxf(__uint_as_float(rr[0]), __uint_as_float(rr[1])); }
__device__ __forceinline__ float half_sum(float m) { auto rr = __builtin_amdgcn_permlane32_swap(__float_as_uint(m), __float_as_uint(m), false, false); return __uint_as_float(rr[0]) + __uint_as_float(rr[1]); }
#define MX3(a, b, c) __builtin_fmaxf(__builtin_fmaxf((a), (b)), (c))

__device__ __forceinline__ void glds16(const void* gsrc, unsigned lds_dst) { unsigned keep;
    asm volatile("s_mov_b32 %0, m0\n\ts_mov_b32 m0, %2\n\ts_nop 0\n\tglobal_load_lds_dwordx4 %1, off\n\ts_mov_b32 m0, %0" : "=&s"(keep) : "v"(gsrc), "s"(lds_dst) : "memory"); }
template <int MODE, bool NM = false> __device__ __forceinline__ void attn_unit(LAS unsigned char* lds, const AttnP& P, int b, int qhead, int kvh, int qpos0, int qrow0, int tlo, int thi, int sinkidx) {
    int tid_l = threadIdx.x; asm volatile("" : "+v"(tid_l));
    const int tid = tid_l, lane = tid & 63, wid = __builtin_amdgcn_readfirstlane(tid >> 6), r32 = lane & 31, hi = lane >> 5;
    constexpr int RM = (MODE == 0) ? 7 : 3;
    LAS unsigned char* ldsK = lds; LAS unsigned char* ldsV = lds + (MODE == 0 ? 65536 : 32768);
    LAS float* tab = (LAS float*)(lds + 65536);
    volatile LAS int* qw = (volatile LAS int*)(lds + 65536 + 4096);
    const unsigned ldsK0 = (unsigned)(size_t)ldsK, ldsV0 = (unsigned)(size_t)ldsV;
    const int vlane = hi * 512 + ((lane >> 4) & 1) * 128 + ((lane & 15) >> 2) * 32 + (lane & 3) * 8;
    constexpr float THR = 8.0f;
    {
        const int nsteps = 4 + (thi - tlo);
        const bf16_t* kbase = P.Kf + (size_t)((b * 8 + kvh) * KT) * 4096 + tid * 8;
        const bf16_t* vbase = P.Vf + (size_t)((b * 8 + kvh) * KT) * 4096 + tid * 8;
        bf16x8 qf[4];
        { const bf16_t* qp = P.Q + (size_t)(qrow0 + wid * 32 + r32) * DM + qhead * 64 + hi * 8;
#pragma unroll
          for (int d0 = 0; d0 < 4; ++d0) qf[d0] = *(const bf16x8*)(qp + d0 * 16); }
        if (MODE == 1) { for (int i = tid; i < 15 * 31; i += 512) tab[i] = P.rpb[qhead * 465 + i] * LOG2E; }
        const int qw0 = qpos0 + wid * 32;
        const int qpos = qw0 + r32;
        float mref = 0.f, lrun = 0.f;
        f32x16 o0, o1, negm;
#pragma unroll
        for (int i = 0; i < 16; ++i) { o0[i] = 0.f; o1[i] = 0.f; negm[i] = 0.f; }
#define ATT_TILE(s_) ((s_) < 4 ? 32 + (s_) : tlo + (s_) - 4)
#define ATT_DMA(s_) do { const int tt_ = ATT_TILE(s_); const unsigned sl_ = (unsigned)(((s_) & RM) * 8192 + wid * 1024); \
            glds16(kbase + (size_t)tt_ * 4096, (unsigned)__builtin_amdgcn_readfirstlane(ldsK0 + sl_)); \
            glds16(vbase + (size_t)tt_ * 4096, (unsigned)__builtin_amdgcn_readfirstlane(ldsV0 + sl_)); } while (0)
        ATT_DMA(0); ATT_DMA(1); ATT_DMA(2);
        if (MODE == 0) { ATT_DMA(3); }
        asm volatile("s_waitcnt vmcnt(0)" : "+v"(qf[0]), "+v"(qf[1]), "+v"(qf[2]), "+v"(qf[3]) :: "memory");
        for (int st = 0; st < nsteps; ++st) {
            if (MODE == 0) {
                if ((st & 3) == 0) {
                    asm volatile("s_waitcnt vmcnt(0)" ::: "memory");
                    asm volatile("s_waitcnt lgkmcnt(0)" ::: "memory");
                    __builtin_amdgcn_s_barrier();
                    asm volatile("" ::: "memory");
                    if (st + 4 < nsteps) { ATT_DMA(st + 4); ATT_DMA(st + 5); ATT_DMA(st + 6); ATT_DMA(st + 7); } }
            } else {
            const int rem = nsteps - 1 - st;
            if (rem >= 2) asm volatile("s_waitcnt vmcnt(4)" ::: "memory"); else if (rem == 1) asm volatile("s_waitcnt vmcnt(2)" ::: "memory"); else asm volatile("s_waitcnt vmcnt(0)" ::: "memory");
            asm volatile("s_waitcnt lgkmcnt(0)" ::: "memory");
            __builtin_amdgcn_s_barrier();
            asm volatile("" ::: "memory");
            if (st + 3 < nsteps) ATT_DMA(st + 3);
            }
            const int t = ATT_TILE(st);
            const int buf = st & RM;
            bool skip = false;
            if (st >= 4) {
                if (MODE == 1) { const int qr = qw0 >> 6, rs = min(max(qr - 4, 0), 24); skip = (t < rs) || (t >= rs + 8); }
                else if (MODE == 2) { skip = (64 * t > qw0 + 31 + 128) || (64 * t + 63 < qw0 - 128); }
            }
            if (!skip) {
            const LAS unsigned char* kb = ldsK + buf * 8192 + lane * 16;
            const LAS unsigned char* vb = ldsV + buf * 8192 + vlane;
            f32x16 s0, s1;
            {
                bf16x8 kf[8];
#pragma unroll
                for (int i = 0; i < 8; ++i) kf[i] = *(const LAS bf16x8*)(kb + i * 1024);
                __builtin_amdgcn_sched_barrier(0);
                if (NM) { const f32x16 z = {0.f, 0.f, 0.f, 0.f, 0.f, 0.f, 0.f, 0.f, 0.f, 0.f, 0.f, 0.f, 0.f, 0.f, 0.f, 0.f};
                    s0 = __builtin_amdgcn_mfma_f32_32x32x16_bf16(kf[0], qf[0], z, 0, 0, 0); s1 = __builtin_amdgcn_mfma_f32_32x32x16_bf16(kf[4], qf[0], z, 0, 0, 0); }
                else { s0 = __builtin_amdgcn_mfma_f32_32x32x16_bf16(kf[0], qf[0], negm, 0, 0, 0); s1 = __builtin_amdgcn_mfma_f32_32x32x16_bf16(kf[4], qf[0], negm, 0, 0, 0); }
#pragma unroll
                for (int d0 = 1; d0 < 4; ++d0) { s0 = __builtin_amdgcn_mfma_f32_32x32x16_bf16(kf[d0], qf[d0], s0, 0, 0, 0); s1 = __builtin_amdgcn_mfma_f32_32x32x16_bf16(kf[4 + d0], qf[d0], s1, 0, 0, 0); }
                __builtin_amdgcn_sched_barrier(0);
            }
            v4i16_t vlo[8], vhi[8];
#pragma unroll
            for (int i = 0; i < 8; ++i) { vlo[i] = __builtin_amdgcn_ds_read_tr16_b64_v4i16((LAS v4i16_t*)(vb + (i & 3) * 2048 + (i >> 2) * 256));
                                          vhi[i] = __builtin_amdgcn_ds_read_tr16_b64_v4i16((LAS v4i16_t*)(vb + (i & 3) * 2048 + (i >> 2) * 256 + 1024)); }
            __builtin_amdgcn_sched_barrier(0);
            if (st >= 4) {
                if (MODE == 2 && !((64 * t >= qw0 + 31 - 128) && (64 * t + 63 <= qw0 + 128))) {
                    const int base = qpos - 64 * t - 4 * hi;
#pragma unroll
                    for (int i = 0; i < 16; ++i) { const int d = base - ((i & 3) + 8 * (i >> 2));
                        if (d > 128 || d < -128) s0[i] = NEGBIG;
                        if (d - 32 > 128 || d - 32 < -128) s1[i] = NEGBIG;
                        if ((i & 3) == 3) asm volatile("" : "+v"(s0), "+v"(s1)); }
                } else if (MODE == 1) {
                    const int qr = qpos >> 6, qc = qpos & 63;
                    const int cs = min(max(qc - 8, 0), 48);
                    const int tb = (t - qr + 7) * 31 + 15 - qc;
#pragma unroll
                    for (int i = 0; i < 16; ++i) { const int kk = 4 * hi + (i & 3) + 8 * (i >> 2);
                        const bool ok0 = kk >= cs && kk < cs + 16;
                        const bool ok1 = kk + 32 >= cs && kk + 32 < cs + 16;
                        int i0_ = ok0 ? tb + kk : 0, i1_ = ok1 ? tb + kk + 32 : 0; asm volatile("" : "+v"(i0_), "+v"(i1_));
                        const float b0 = tab[i0_], b1 = tab[i1_];
                        s0[i] = ok0 ? s0[i] + b0 : NEGBIG; s1[i] = ok1 ? s1[i] + b1 : NEGBIG;
                        if ((i & 3) == 3) asm volatile("" ::: "memory"); }
                }
            }
            if (!NM) {
            float ma = MX3(s0[0], s0[1], s1[0]), mb = MX3(s0[2], s0[3], s1[1]); ma = MX3(ma, s1[2], s1[3]);
#pragma unroll
            for (int r = 4; r < 16; r += 4) { ma = MX3(ma, s0[r], s0[r + 1]); mb = MX3(mb, s0[r + 2], s0[r + 3]); ma = MX3(ma, s1[r], s1[r + 1]); mb = MX3(mb, s1[r + 2], s1[r + 3]); }
            const float mx = half_max(fmaxf(ma, mb));
            if (st == 0) {
                mref = mx;
#pragma unroll
                for (int i = 0; i < 16; ++i) { s0[i] -= mx; s1[i] -= mx; negm[i] = -mx; }
            } else if (__any(mx > THR)) {
                const float dl = fmaxf(mx, 0.f); mref += dl;
                const float f = __builtin_amdgcn_exp2f(-dl); lrun *= f;
#pragma unroll
                for (int i = 0; i < 16; ++i) { s0[i] -= dl; s1[i] -= dl; negm[i] = -mref; o0[i] *= f; o1[i] *= f; }
            }
            }
            float lsa = 0.f, lsb = 0.f;
#pragma unroll
            for (int i = 0; i < 16; i += 2) { s0[i] = __builtin_amdgcn_exp2f(s0[i]); s0[i + 1] = __builtin_amdgcn_exp2f(s0[i + 1]); s1[i] = __builtin_amdgcn_exp2f(s1[i]); s1[i + 1] = __builtin_amdgcn_exp2f(s1[i + 1]);
                lsa += s0[i]; lsb += s0[i + 1]; asm volatile("" : "+v"(lsa), "+v"(lsb)); lsa += s1[i]; lsb += s1[i + 1]; asm volatile("" : "+v"(lsa), "+v"(lsb)); }
            lrun += lsa + lsb;
            u32x4 pw[4];
#pragma unroll
            for (int c = 0; c < 2; ++c) {
                pw[c].x = cvt_pk_bf16(s0[8 * c + 0], s0[8 * c + 1]); pw[c].y = cvt_pk_bf16(s0[8 * c + 2], s0[8 * c + 3]); pw[c].z = cvt_pk_bf16(s0[8 * c + 4], s0[8 * c + 5]); pw[c].w = cvt_pk_bf16(s0[8 * c + 6], s0[8 * c + 7]);
                pw[2 + c].x = cvt_pk_bf16(s1[8 * c + 0], s1[8 * c + 1]); pw[2 + c].y = cvt_pk_bf16(s1[8 * c + 2], s1[8 * c + 3]); pw[2 + c].z = cvt_pk_bf16(s1[8 * c + 4], s1[8 * c + 5]); pw[2 + c].w = cvt_pk_bf16(s1[8 * c + 6], s1[8 * c + 7]); }
            __builtin_amdgcn_sched_barrier(0);
#pragma unroll
            for (int c = 0; c < 4; ++c) {
                const bf16x8 v0 = (bf16x8){vlo[c][0], vlo[c][1], vlo[c][2], vlo[c][3], vhi[c][0], vhi[c][1], vhi[c][2], vhi[c][3]};
                const bf16x8 v1 = (bf16x8){vlo[4 + c][0], vlo[4 + c][1], vlo[4 + c][2], vlo[4 + c][3], vhi[4 + c][0], vhi[4 + c][1], vhi[4 + c][2], vhi[4 + c][3]};
                const bf16x8 pf = __builtin_bit_cast(bf16x8, pw[c]);
                o0 = __builtin_amdgcn_mfma_f32_32x32x16_bf16(v0, pf, o0, 0, 0, 0);
                o1 = __builtin_amdgcn_mfma_f32_32x32x16_bf16(v1, pf, o1, 0, 0, 0); }
            }
        }
        lrun = half_sum(lrun);
        if (sinkidx >= 0) lrun += __builtin_amdgcn_exp2f(P.sink[sinkidx] * LOG2E - mref);
        const float inv = 1.0f / lrun;
        bf16_t* op = P.O + (size_t)(qrow0 + wid * 32 + r32) * DM + qhead * 64 + 4 * hi;
#pragma unroll
        for (int g = 0; g < 4; ++g) {
            u32x2 w; w.x = cvt_pk_bf16(o0[4 * g] * inv, o0[4 * g + 1] * inv); w.y = cvt_pk_bf16(o0[4 * g + 2] * inv, o0[4 * g + 3] * inv);
            *(u32x2*)(op + 8 * g) = w;
            u32x2 w2; w2.x = cvt_pk_bf16(o1[4 * g] * inv, o1[4 * g + 1] * inv); w2.y = cvt_pk_bf16(o1[4 * g + 2] * inv, o1[4 * g + 3] * inv);
            *(u32x2*)(op + 32 + 8 * g) = w2; }
        __syncthreads();
    }
}

__device__ __forceinline__ void attn_phase(LAS unsigned char* lds, const AttnP P) {
    volatile LAS int* qw = (volatile LAS int*)(lds + 131072 + 128);
    const bool xcdq = (gridDim.x == 256);
    const unsigned myx = xb_xcc_id() & 7u;
    bool bdone = !xcdq;
#define ATT_FETCH(dst_) do { int r_ = -1; \
        if (!bdone) { const unsigned j_ = atomicAdd(P.xq + 8 * myx, 1u); \
            if (j_ < 64u) { const unsigned gi_ = myx + 8u * (j_ >> 5), r2_ = j_ & 31u; r_ = (int)((gi_ >> 1) * 64u + ((gi_ & 1u) * 4u + (r2_ >> 3)) * 8u + (r2_ & 7u)); } else bdone = true; } \
        if (r_ < 0) r_ = (xcdq ? 512 : 0) + (int)atomicAdd(P.counter, 1u); \
        dst_ = r_; } while (0)
    int nxt = 0;
    if (threadIdx.x == 0) ATT_FETCH(nxt);
    for (;;) {
        if (threadIdx.x == 0) qw[0] = nxt;
        __syncthreads();
        const int u = qw[0];
        if (u >= P.nunits) break;
        if (threadIdx.x == 0) ATT_FETCH(nxt);
        int mode, b, qhead, kvh, qpos0 = 0, qrow0, tlo = 0, thi = 0, sinkidx = -1;
        if (u < 512) { mode = 0; b = u >> 6; const int g = (u >> 3) & 7, qb = u & 7; qhead = 4 + g; kvh = 4 + (g >> 2); qpos0 = qb * 256; qrow0 = b * SEQ + qpos0; tlo = 0; thi = 32; }
        else if (u < 768) { const int v = u - 512; mode = 1; b = v >> 5; const int h = (v >> 3) & 3, qb = v & 7; qhead = h; kvh = h; qpos0 = qb * 256; qrow0 = b * SEQ + qpos0;
            const int r0 = 4 * qb; tlo = min(max(r0 - 4, 0), 24); thi = min(max(r0 - 1, 0), 24) + 8; }
        else if (u < 1024) { const int v = u - 768; mode = 2; b = v >> 5; const int h = (v >> 3) & 3, qb = v & 7; qhead = 12 + h; kvh = 6 + (h >> 1); qpos0 = qb * 256; qrow0 = b * SEQ + qpos0;
            tlo = max(0, 4 * qb - 2); thi = min(32, 4 * qb + 6); sinkidx = h; }
        else { const int v = u - 1024; mode = 3; b = v >> 4; qhead = v & 15; kvh = qhead < 4 ? qhead : (qhead < 12 ? 4 + ((qhead - 4) >> 2) : 6 + ((qhead - 12) >> 1)); qrow0 = ML + b * CTXL;
            if (qhead >= 12) sinkidx = qhead - 12; }
        if (mode == 1) attn_unit<1>(lds, P, b, qhead, kvh, qpos0, qrow0, tlo, thi, sinkidx);
        else if (mode == 2) attn_unit<2>(lds, P, b, qhead, kvh, qpos0, qrow0, tlo, thi, sinkidx);
        else if (P.bbound < 64.0f && qhead >= 4 && qhead < 12) attn_unit<0, true>(lds, P, b, qhead, kvh, qpos0, qrow0, tlo, thi, sinkidx);
        else attn_unit<0>(lds, P, b, qhead, kvh, qpos0, qrow0, tlo, thi, sinkidx);
    }
}

__global__ void __launch_bounds__(512, 2) mega_fwd(Args a) {
    extern __shared__ __attribute__((aligned(16))) unsigned char lds_raw[];
    LAS unsigned char* lds = (LAS unsigned char*)lds_raw;
    cg::grid_group grid = cg::this_grid();
    volatile LAS unsigned* bst = (volatile LAS unsigned*)(lds + 131072 + 64);
    if (threadIdx.x == 0) { bst[0] = 0u; bst[1] = 0u; }
    __syncthreads();
    const XcdBarrier xbar = xcd_barrier_post((unsigned*)(a.ws + WS_CTL) + 4096, bst);
#ifndef PH
#define PH 0xFFF
#endif
#ifndef PROBE
#define PROBE 0
#endif
#define PHASE_BEGIN() unsigned char* ws = a.ws; int G = gridDim.x, bx = blockIdx.x; asm volatile("" : "+s"(ws), "+s"(G), "+s"(bx))
    if (PH & 1) prologue(a, lds);
    if (PROBE == 5) { __syncthreads(); prologue(a, lds); }
    if (a.ws == nullptr) grid.sync();
    xcd_barrier(xbar);

    for (int l = 0; l < DEPTH; ++l) {
        const bool last = (l == DEPTH - 1);
        const int Mff = last ? ML : MT;
        if (PH & 2) { PHASE_BEGIN(); (void)G; (void)bx;
            const float* modl = (const float*)(ws + WS_MOD) + (size_t)l * 9 * NMOD; float* X = (float*)(ws + WS_X); bf16_t* H = (bf16_t*)(ws + WS_H);
            const float* cp = (const float*)(ws + WS_CP);
            if (l == 0) norm_phase(a.in[0], a.in[2], X, cp + CP_AN, modl, 0, 1024, H, MT);
            else        norm_phase(X, X + (size_t)ML * DM, nullptr, cp + CP_AN + l * DM, modl, 0, 1024, H, MT, gridDim.x == 256 ? (const bf16_t*)(ws + WS_PB) : (const bf16_t*)nullptr); }
        xcd_barrier(xbar); if (PROBE == 4) xcd_barrier(xbar);
        if (PH & 4) { PHASE_BEGIN();
          pg8::Gemm g{(bf16_t*)(ws + WS_H), (bf16_t*)(ws + WS_WIN) + (size_t)l * DPROJ * DM, MT, DPROJ, DM}; pg8::StaticOrder S; S.init(MT, DPROJ, G, bx);
          const float* cosT = (const float*)(ws + WS_ROPE);
          EpiQKV E{(bf16_t*)(ws + WS_Q), (bf16_t*)(ws + WS_K), (bf16_t*)(ws + WS_V), (const float*)(ws + WS_GAIN) + l * 128, cosT, cosT + SEQ * 32};
          pg8::gemm_phase<EpiQKV, pg8::StaticOrder, true, true>(lds, g, S, E);
          if (PROBE == 2) { xcd_barrier(xbar); pg8::gemm_phase<EpiQKV, pg8::StaticOrder, true, true>(lds, g, S, E); } }
        xcd_barrier(xbar); if (PROBE == 4) xcd_barrier(xbar);
        if (PH & 8) { PHASE_BEGIN(); (void)G; (void)bx;
          const float* cp = (const float*)(ws + WS_CP);
          AttnP P{(bf16_t*)(ws + WS_Q), (bf16_t*)(ws + WS_O), (bf16_t*)(ws + WS_K), (bf16_t*)(ws + WS_V), cp + CP_RPB + l * 4 * 465, cp + CP_SINK + l * 4, (unsigned*)(ws + WS_CTL) + 64 * l, last ? 1024 : 1152, *((const float*)(ws + WS_GAIN) + 512 + l), (unsigned*)(ws + WS_CTL) + 2048 + 64 * l};
          attn_phase(lds, P);
          if (PROBE == 1) { xcd_barrier(xbar); AttnP P2 = P; P2.counter = (unsigned*)(ws + WS_CTL) + 64 * (l + 4); attn_phase(lds, P2); } }
        xcd_barrier(xbar); if (PROBE == 4) xcd_barrier(xbar);
        if (PH & 16) { PHASE_BEGIN();
          pg8::Gemm g{(bf16_t*)(ws + WS_O), (bf16_t*)(ws + WS_WOUT) + (size_t)l * DM * DM, Mff, DM, DM}; pg8::SplitCtxOrder S; S.init(Mff, DM, G, bx);
          EpiRes E{(float*)(ws + WS_X), (l == 0 && G == 256) ? a.in[0] : (const float*)(ws + WS_X), (const float*)(ws + WS_MOD) + (size_t)l * 9 * NMOD, 2048, (bf16_t*)(ws + WS_PB)};
          pg8::gemm_phase<EpiRes, pg8::SplitCtxOrder, true, true>(lds, g, S, E); }
        xcd_barrier(xbar); if (PROBE == 4) xcd_barrier(xbar);
        if (PH & 32) { PHASE_BEGIN(); (void)G; (void)bx;
            const float* modl = (const float*)(ws + WS_MOD) + (size_t)l * 9 * NMOD; float* X = (float*)(ws + WS_X);
            const float* cp = (const float*)(ws + WS_CP);
            norm_phase(X, X + (size_t)ML * DM, nullptr, cp + CP_FN + l * DM, modl, 3072, 4096, (bf16_t*)(ws + WS_H), Mff, (last || gridDim.x != 256) ? (const bf16_t*)nullptr : (const bf16_t*)(ws + WS_PB)); }
        xcd_barrier(xbar); if (PROBE == 4) xcd_barrier(xbar);
        if (PH & 64) { PHASE_BEGIN();
          pg8::Gemm g{(bf16_t*)(ws + WS_H), (bf16_t*)(ws + WS_WUP) + (size_t)l * 2 * DFF * DM, Mff, 2 * DFF, DM}; pg8::StaticOrder S; S.init(Mff, 2 * DFF, G, bx);
          const float* cp = (const float*)(ws + WS_CP) + CP_CONV;
          EpiUp E{(bf16_t*)(ws + WS_HID), (float*)(ws + WS_EDGE), cp + (size_t)l * 4 * DFF, cp + (size_t)l * 4 * DFF + 3 * DFF};
          pg8::gemm_phase<EpiUp, pg8::StaticOrder, true, true>(lds, g, S, E);
          if (PROBE == 3) { xcd_barrier(xbar); pg8::gemm_phase<EpiUp, pg8::StaticOrder, true, true>(lds, g, S, E); } }
        xcd_barrier(xbar); if (PROBE == 4) xcd_barrier(xbar);
        if (PH & 256) { PHASE_BEGIN();
          pg8::Gemm g{(bf16_t*)(ws + WS_HID), (bf16_t*)(ws + WS_WDN) + (size_t)l * DM * DFF, Mff, DM, DFF}; pg8::SplitCtxOrder S; S.init(Mff, DFF, G, bx);
          EpiRes E{(float*)(ws + WS_X), (const float*)(ws + WS_X), (const float*)(ws + WS_MOD) + (size_t)l * 9 * NMOD, 5120, (bf16_t*)(ws + WS_PB)};
          { const float* cpc = (const float*)(ws + WS_CP) + CP_CONV + (size_t)l * 4 * DFF; pg8::Unit fu;
            for (int i = 0; S.next(i, fu); ++i) fixup_tile((const float*)(ws + WS_EDGE), cpc, (bf16_t*)(ws + WS_HID), 4 * fu.pm);
            __syncthreads(); }
          pg8::gemm_phase<EpiRes, pg8::SplitCtxOrder, true, true>(lds, g, S, E); }
        xcd_barrier(xbar); if (PROBE == 4) xcd_barrier(xbar);
    }
    if (PH & 512) { PHASE_BEGIN(); (void)G; (void)bx; final_norm_phase((const float*)(ws + WS_X), (const float*)(ws + WS_CP) + CP_FIN, a.out); }
}

extern "C" void kernel_launch(void* const* d_in, const int* in_sizes, int n_in, void* d_out, int out_size, void* d_ws, size_t ws_size, hipStream_t stream) {
    static int grid = 0;
    if (grid == 0) {
        if (n_in != 19 || ws_size < WS_END) { fprintf(stderr, "kernel_launch: unexpected n_in %d or ws_size %zu (< %zu)\n", n_in, ws_size, (size_t)WS_END); grid = -1; return; }
        int dev = 0, cus = 0, per_cu = 0;
        (void)hipGetDevice(&dev);
        (void)hipDeviceGetAttribute(&cus, hipDeviceAttributeMultiprocessorCount, dev);
        if (hipFuncSetAttribute((const void*)mega_fwd, hipFuncAttributeMaxDynamicSharedMemorySize, LDS_BYTES) != hipSuccess) fprintf(stderr, "kernel_launch: hipFuncSetAttribute failed\n");
        if (hipOccupancyMaxActiveBlocksPerMultiprocessor(&per_cu, (const void*)mega_fwd, 512, LDS_BYTES) != hipSuccess || per_cu < 1) { fprintf(stderr, "kernel_launch: occupancy query says %d\n", per_cu); per_cu = 1; }
        (void)hipGetLastError();
        grid = cus * per_cu;
        fprintf(stderr, "kernel_launch: grid %d (cus %d x %d)\n", grid, cus, per_cu);
    }
    if (grid < 0) return;
    (void)hipMemsetAsync(d_ws, 0, 65536, stream);
    Args a{};
    for (int i = 0; i < 19; ++i) a.in[i] = (const float*)d_in[i];
    a.out = (float*)d_out; a.ws = (unsigned char*)d_ws;
    void* args[] = {&a};
    hipError_t e = hipLaunchCooperativeKernel((const void*)mega_fwd, dim3(grid), dim3(512), args, LDS_BYTES, stream);
    if (e != hipSuccess) fprintf(stderr, "kernel_launch: cooperative launch failed: %s (grid %d)\n", hipGetErrorString(e), grid);
}
```

```cpp
#include <hip/hip_runtime.h>
#include <hip/hip_cooperative_groups.h>
#include <cstdio>
#include <cstdint>
namespace cg = cooperative_groups;
namespace pg8 {
#define PG8_LAS __attribute__((address_space(3)))
typedef unsigned short bf16_t;
typedef short bf16x8 __attribute__((ext_vector_type(8)));
typedef float f32x4 __attribute__((ext_vector_type(4)));
typedef unsigned u32x4 __attribute__((ext_vector_type(4)));
constexpr int BM = 256, BK = 64, HALF = 128, HTB = HALF * BK * 2  , STAGE_BYTES = 8 * HTB, NXCD = 8, WGM = 8;

__host__ __device__ __forceinline__ int lds_byte(int r, int c) { const int st = (r >> 4) * 2 + (c >> 5), rr = r & 15, cc = c & 31, ob = rr * 64 + cc * 2; return st * 1024 + (ob ^ (((ob >> 9) & 1) << 5)); }
__host__ __device__ __forceinline__ void stage_rc(int b, int& R, int& C) { const int st = b / 1024, sb = b % 1024, swz = sb ^ (((sb >> 9) & 1) << 5); R = (st >> 1) * 16 + swz / 64; C = (st & 1) * 32 + (swz % 64) / 2; }
__host__ __device__ __forceinline__ int perm32(int rho) { const int n = rho >> 4, i = rho & 15; return 8 * (i >> 2) + 4 * n + (i & 3); }

struct Unit { int pm, pn, kt0, nt, part; };
struct Gemm { const bf16_t* A; const bf16_t* Bt; int M, N, K; };

struct StaticOrder {
    int nM, nN, nwg, G, c, ntf;
    __host__ __device__ void init(int M, int N, int G_, int c_, int K_ = 1024) { nM = M / BM; nN = N / BM; nwg = nM * nN; G = G_; c = c_; ntf = K_ / BK; }
    __host__ __device__ bool next(int i, Unit& u) const {
        const long L = (long)i * G + c; if (L >= nwg) return false;
        int wgid = (int)L; { const int q = nwg / NXCD, r = nwg % NXCD, xcd = wgid % NXCD, off = wgid / NXCD; wgid = (xcd < r ? xcd * (q + 1) : r * (q + 1) + (xcd - r) * q) + off; }
        const int wgm = (nM % NXCD == 0) ? nM / NXCD : WGM;
        const int nig = wgm * nN, gid = wgid / nig, fm = gid * wgm, gsz = (nM - fm) < wgm ? (nM - fm) : wgm;
        u.pm = fm + ((wgid % nig) % gsz); u.pn = (wgid % nig) / gsz; u.kt0 = 0; u.nt = ntf; u.part = 0; return true;
    }
    __device__ __forceinline__ void a_ready(const Unit&) const {}
    __device__ __forceinline__ void done(const Unit&) const {}
};


struct SplitCtxOrder {
    StaticOrder lat, all; bool split; int c, ntf;
    __host__ __device__ void init(int M, int K, int G, int c_) { c = c_; ntf = K / BK; split = (G == 256) && (M > 16384); lat.init(16384, 1024, G, c_, K); all.init(M, 1024, G, c_, K); }
    __host__ __device__ bool next(int i, Unit& u) const {
        Unit a; a.pm = 0; a.pn = 0; a.kt0 = 0; a.nt = ntf; a.part = 0; bool ok;
        if (!split) { Unit t; t.pm = 0; t.pn = 0; t.kt0 = 0; t.nt = ntf; t.part = 0; ok = all.next(i, t); a = t; }
        else if (i == 0) { Unit t; t.pm = 0; t.pn = 0; t.kt0 = 0; t.nt = ntf; t.part = 0; ok = lat.next(0, t); a = t; }
        else { ok = (i == 1) && (c < 128); const int cu = c >> 2, sl = c & 3;
            a.pm = 64 + (cu >> 2); a.pn = cu & 3; a.part = 1 + sl;
            a.kt0 = ntf == 16 ? 4 * sl : (sl == 0 ? 0 : sl == 1 ? 12 : sl == 2 ? 24 : 34); a.nt = ntf == 16 ? 4 : (sl < 2 ? 12 : 10); }
        u.pm = a.pm; u.pn = a.pn; u.kt0 = a.kt0; u.nt = a.nt; u.part = a.part; return ok;
    }
    __device__ __forceinline__ void a_ready(const Unit&) const {}
    __device__ __forceinline__ void done(const Unit&) const {}
};
__device__ __forceinline__ unsigned cvt_pk_bf16(float lo, float hi) { unsigned r; asm volatile("v_cvt_pk_bf16_f32 %0, %1, %2" : "=v"(r) : "v"(lo), "v"(hi)); return r; }
template <class Epi, class Sched, bool ALIGN_EPI = false, bool SP2 = false>
__device__ __forceinline__ void gemm_phase(PG8_LAS unsigned char* lds, const Gemm g, const Sched& S, const Epi& E) {
    int tid_l = threadIdx.x; asm volatile("" : "+v"(tid_l));
    const int tid = tid_l, wid = __builtin_amdgcn_readfirstlane(tid >> 6), lane = tid & 63, wr = wid >> 2, wc = wid & 3, fr = lane & 15, fq = lane >> 4;
    const int K = g.K;
    unsigned voffA[2], voffB[2];
#pragma unroll
    for (int i = 0; i < 2; ++i) { int R, C; stage_rc(tid * 16 + i * 8192, R, C); const int Rb = Epi::PERM ? ((R & ~31) + perm32(R & 31)) : R;
        voffA[i] = (unsigned)(R * K + C) * 2u; voffB[i] = (unsigned)(Rb * K + C) * 2u; }
    const size_t kstep = (size_t)(BK * 2);
    const size_t hstep = (size_t)HALF * K * 2;
    const size_t tstep = 2 * hstep;
    const unsigned ldsw = (unsigned)wid * 1024u;
    const int aoff = lds_byte(wr * 64 + fr, fq * 8), boff = lds_byte(wc * 32 + fr, fq * 8);
#define PG8_SA(b, h) (((b) * 2 + (h)) * HTB)
#define PG8_SB(b, h) ((4 + (b) * 2 + (h)) * HTB)
#define PG8_STAGE(bufoff, gbase, voff) do { _Pragma("unroll") for (int _i = 0; _i < 2; ++_i) \
        __builtin_amdgcn_global_load_lds((const unsigned*)((const char*)(gbase) + (voff)[_i]), (PG8_LAS unsigned*)(lds + (bufoff) + ldsw + _i * 8192), 16, 0, 0); } while (0)
#define PG8_LDA(dst, b, h) do { _Pragma("unroll") for (int m = 0; m < 4; ++m) _Pragma("unroll") for (int k = 0; k < 2; ++k) dst[m][k] = *(const PG8_LAS bf16x8*)(lds + PG8_SA(b, h) + aoff + m * 2048 + k * 1024); } while (0)
#define PG8_LDB(dst, b, h) do { _Pragma("unroll") for (int n = 0; n < 2; ++n) _Pragma("unroll") for (int k = 0; k < 2; ++k) dst[n][k] = *(const PG8_LAS bf16x8*)(lds + PG8_SB(b, h) + boff + n * 2048 + k * 1024); } while (0)
#define PG8_MMA(ai, bj, At, Bt) do { __builtin_amdgcn_s_setprio(1); _Pragma("unroll") for (int m = 0; m < 4; ++m) _Pragma("unroll") for (int n = 0; n < 2; ++n) _Pragma("unroll") for (int k = 0; k < 2; ++k) \
        acc[ai][bj][m][n] = __builtin_amdgcn_mfma_f32_16x16x32_bf16(Bt[n][k], At[m][k], acc[ai][bj][m][n], 0, 0, 0); __builtin_amdgcn_s_setprio(0); } while (0)
#define PG8_WAIT_V(n) asm volatile("s_waitcnt vmcnt(" #n ")" ::: "memory")
#define PG8_WAIT_L(n) asm volatile("s_waitcnt lgkmcnt(" #n ")" ::: "memory")
#define PG8_BAR __builtin_amdgcn_s_barrier()
#define PG8_SCHED __builtin_amdgcn_sched_barrier(0)
    Unit cur, nxt; int ui = 0;
    if (!S.next(0, cur)) return;
    int nt = cur.nt;
    f32x4 acc[2][2][4][2];
#pragma unroll
    for (int a = 0; a < 2; ++a)
#pragma unroll
        for (int b = 0; b < 2; ++b)
#pragma unroll
            for (int m = 0; m < 4; ++m)
#pragma unroll
                for (int n = 0; n < 2; ++n) acc[a][b][m][n] = (f32x4){0.f, 0.f, 0.f, 0.f};
    bf16x8 At[4][2], B0[2][2], B1[2][2];
    const char* cA = (const char*)g.A + (size_t)cur.pm * tstep + (size_t)cur.kt0 * kstep; const char* cB = (const char*)g.Bt + (size_t)cur.pn * tstep + (size_t)cur.kt0 * kstep;
    S.a_ready(cur);
    if constexpr (SP2) {
        PG8_STAGE(PG8_SB(0, 0), cB, voffB); PG8_STAGE(PG8_SB(0, 1), cB + hstep, voffB); PG8_STAGE(PG8_SA(0, 0), cA, voffA); PG8_STAGE(PG8_SA(0, 1), cA + hstep, voffA);
        if (wr == 1) PG8_BAR;
        PG8_WAIT_V(2); PG8_BAR;
        PG8_STAGE(PG8_SB(1, 0), cB + kstep, voffB); PG8_STAGE(PG8_SA(1, 0), cA + kstep, voffA); PG8_STAGE(PG8_SB(1, 1), cB + hstep + kstep, voffB);
        PG8_WAIT_V(6); PG8_BAR;
    } else {
        PG8_STAGE(PG8_SB(0, 0), cB, voffB); PG8_STAGE(PG8_SA(0, 0), cA, voffA); PG8_STAGE(PG8_SB(0, 1), cB + hstep, voffB); PG8_STAGE(PG8_SA(0, 1), cA + hstep, voffA);
        if (wr == 1) PG8_BAR;
        PG8_WAIT_V(4); PG8_BAR;
        PG8_STAGE(PG8_SB(1, 0), cB + kstep, voffB); PG8_STAGE(PG8_SA(1, 0), cA + kstep, voffA); PG8_STAGE(PG8_SB(1, 1), cB + hstep + kstep, voffB);
        PG8_WAIT_V(6); PG8_BAR;
    }
    for (;;) {
        const bool has_next = S.next(ui + 1, nxt);
        const char* nA = has_next ? (const char*)g.A + (size_t)nxt.pm * tstep + (size_t)nxt.kt0 * kstep : cA; const char* nB = has_next ? (const char*)g.Bt + (size_t)nxt.pn * tstep + (size_t)nxt.kt0 * kstep : cB;
        for (int t = 0; t < nt; t += 2) {
            const bool last = (t == nt - 2);
            const char* a1 = cA + (size_t)(t + 1) * kstep;
            const char* a2 = last ? nA : cA + (size_t)(t + 2) * kstep; const char* b2 = last ? nB : cB + (size_t)(t + 2) * kstep;
            const char* a3 = a2 + kstep; const char* b3 = b2 + kstep;
            if (last && has_next) S.a_ready(nxt);
            if constexpr (SP2) {
            PG8_LDB(B0, 0, 0); PG8_LDB(B1, 0, 1); PG8_SCHED; PG8_LDA(At, 0, 0); PG8_STAGE(PG8_SA(1, 1), a1 + hstep, voffA);
            PG8_WAIT_V(8); PG8_WAIT_L(0); PG8_BAR; PG8_MMA(0, 0, At, B0); PG8_MMA(0, 1, At, B1); PG8_BAR; PG8_SCHED;
            PG8_LDA(At, 0, 1); PG8_STAGE(PG8_SB(0, 0), b2, voffB); PG8_STAGE(PG8_SB(0, 1), b2 + hstep, voffB); PG8_STAGE(PG8_SA(0, 0), a2, voffA);
            PG8_WAIT_V(8); PG8_WAIT_L(0); PG8_BAR; PG8_MMA(1, 0, At, B0); PG8_MMA(1, 1, At, B1); PG8_BAR; PG8_SCHED;
            PG8_LDB(B0, 1, 0); PG8_LDB(B1, 1, 1); PG8_SCHED; PG8_LDA(At, 1, 0); PG8_STAGE(PG8_SA(0, 1), a2 + hstep, voffA);
            PG8_WAIT_V(8); PG8_WAIT_L(0); PG8_BAR; PG8_MMA(0, 0, At, B0); PG8_MMA(0, 1, At, B1); PG8_BAR; PG8_SCHED;
            PG8_LDA(At, 1, 1); PG8_STAGE(PG8_SB(1, 0), b3, voffB); PG8_STAGE(PG8_SB(1, 1), b3 + hstep, voffB); PG8_STAGE(PG8_SA(1, 0), a3, voffA);
            PG8_WAIT_V(8); PG8_WAIT_L(0); PG8_BAR; PG8_MMA(1, 0, At, B0); PG8_MMA(1, 1, At, B1); PG8_BAR; PG8_SCHED;
            } else {
            PG8_LDB(B0, 0, 0); PG8_SCHED; PG8_LDA(At, 0, 0); PG8_STAGE(PG8_SA(1, 1), a1 + hstep, voffA);
            PG8_WAIT_L(8); PG8_BAR; PG8_WAIT_L(0); PG8_MMA(0, 0, At, B0); PG8_BAR; PG8_SCHED;
            PG8_LDB(B1, 0, 1); PG8_STAGE(PG8_SB(0, 0), b2, voffB);
            PG8_BAR; PG8_WAIT_L(0); PG8_MMA(0, 1, At, B1); PG8_BAR;
            PG8_LDA(At, 0, 1); PG8_STAGE(PG8_SA(0, 0), a2, voffA);
            PG8_BAR; PG8_WAIT_L(0); PG8_MMA(1, 0, At, B0); PG8_BAR; PG8_SCHED;
            PG8_STAGE(PG8_SB(0, 1), b2 + hstep, voffB);
            PG8_WAIT_V(6); PG8_BAR; PG8_MMA(1, 1, At, B1); PG8_BAR;
            PG8_LDB(B0, 1, 0); PG8_SCHED; PG8_LDA(At, 1, 0); PG8_STAGE(PG8_SA(0, 1), a2 + hstep, voffA);
            PG8_WAIT_L(8); PG8_BAR; PG8_WAIT_L(0); PG8_MMA(0, 0, At, B0); PG8_BAR; PG8_SCHED;
            PG8_LDB(B1, 1, 1); PG8_STAGE(PG8_SB(1, 0), b3, voffB);
            PG8_BAR; PG8_WAIT_L(0); PG8_MMA(0, 1, At, B1); PG8_BAR;
            PG8_LDA(At, 1, 1); PG8_STAGE(PG8_SA(1, 0), a3, voffA);
            PG8_BAR; PG8_WAIT_L(0); PG8_MMA(1, 0, At, B0); PG8_BAR; PG8_SCHED;
            PG8_STAGE(PG8_SB(1, 1), b3 + hstep, voffB);
            PG8_WAIT_V(6); PG8_BAR; PG8_MMA(1, 1, At, B1); PG8_BAR;
            }
        }
        if constexpr (ALIGN_EPI) { if (wr == 0) PG8_BAR; }
        if constexpr (!Epi::AFTER_DRAIN) { E(acc, cur, wr, wc, fr, fq); S.done(cur); }
        if (!has_next) break;
#pragma unroll
        for (int a = 0; a < 2; ++a)
#pragma unroll
            for (int b = 0; b < 2; ++b)
#pragma unroll
                for (int m = 0; m < 4; ++m)
#pragma unroll
                    for (int n = 0; n < 2; ++n) acc[a][b][m][n] = (f32x4){0.f, 0.f, 0.f, 0.f};
        cur = nxt; cA = nA; cB = nB; ++ui; nt = cur.nt;
        if constexpr (ALIGN_EPI) { if (wr == 1) PG8_BAR; }
    }
    PG8_WAIT_V(0);
    if constexpr (!ALIGN_EPI) { if (wr == 0) PG8_BAR; }
    PG8_BAR;
    if constexpr (Epi::AFTER_DRAIN) { E.fused(acc, cur, wr, wc, fr, fq, lds, wid, lane); S.done(cur); }
#undef PG8_SA
#undef PG8_SB
#undef PG8_STAGE
#undef PG8_LDA
#undef PG8_LDB
#undef PG8_MMA
#undef PG8_WAIT_V
#undef PG8_WAIT_L
#undef PG8_BAR
#undef PG8_SCHED
}
}

#define GAS __attribute__((address_space(1)))
#define LAS __attribute__((address_space(3)))
typedef unsigned short bf16_t;
typedef float f32x4 __attribute__((ext_vector_type(4)));
typedef float f32x16 __attribute__((ext_vector_type(16)));
typedef short bf16x8 __attribute__((ext_vector_type(8)));
typedef unsigned u32x4 __attribute__((ext_vector_type(4)));
typedef unsigned u32x2 __attribute__((ext_vector_type(2)));
using pg8::cvt_pk_bf16;

constexpr int DM = 1024, NB = 8, SEQ = 2048, CTXL = 256, DEPTH = 4;
constexpr int ML = NB * SEQ, MC = NB * CTXL, MT = ML + MC;
constexpr int DPROJ = 2048, DFF = 2816, NMOD = 6144, KT = 36;
constexpr float EPS = 1e-6f;
constexpr float LOG2E = 1.4426950408889634f;
constexpr float QSCALE = 0.125f * LOG2E;
constexpr float NEGBIG = -1e30f;

constexpr size_t MiB = 1u << 20;
constexpr size_t WS_CTL = 0, WS_WIN = 1 * MiB, WS_WOUT = 17 * MiB, WS_WUP = 25 * MiB, WS_WDN = 69 * MiB, WS_MOD = 91 * MiB, WS_ROPE = 92 * MiB,
                 WS_X = 93 * MiB, WS_H = 165 * MiB, WS_EDGE = 201 * MiB, WS_Q = 221 * MiB, WS_O = 257 * MiB, WS_K = 293 * MiB, WS_V = 311 * MiB,
                 WS_HID = 221 * MiB, WS_PB = 329 * MiB, WS_END = 345 * MiB;
constexpr size_t WS_GAIN = WS_MOD + 917504, WS_CP = WS_ROPE + 524288;
constexpr int CP_AN = 0, CP_FN = 4096, CP_RPB = 8192, CP_SINK = 15632, CP_FIN = 15648, CP_CONV = 16896;
constexpr int LDS_BYTES = 147456;

#define LDS_WAIT() asm volatile("s_waitcnt lgkmcnt(0)" ::: "memory")

#define XB_TMO      128
#define XB_XCNT(j)  (256  + 64 * (j))
#define XB_XSUB(j)  (1280 + 64 * (j))
#define XB_XGEN(j)  (2304 + 64 * (j))
#define XB_TOP      3328
#define XB_TOPGEN   3392
#define XCD_BAR_WORDS 3456
#define XB_SPIN_CAP (1u << 18)

__device__ __forceinline__ unsigned xb_ld(unsigned* p)              { return __hip_atomic_load(p, __ATOMIC_RELAXED, __HIP_MEMORY_SCOPE_AGENT); }
__device__ __forceinline__ unsigned xb_add(unsigned* p, unsigned v) { return __hip_atomic_fetch_add(p, v, __ATOMIC_RELAXED, __HIP_MEMORY_SCOPE_AGENT); }
__device__ __forceinline__ unsigned xb_xcc_id() { return (unsigned)__builtin_amdgcn_s_getreg((3 << 11) | 20) & 0xFu; }
#define XB_SPIN(cond, bar) do { unsigned _sp = 0; while (cond) { __builtin_amdgcn_s_sleep(1); \
    if ((++_sp & 255u) == 0u) { if (xb_ld(&(bar)[XB_TMO])) break; if (_sp > XB_SPIN_CAP) { atomicAdd(&(bar)[XB_TMO], 1u); break; } } } } while (0)

struct XcdBarrier {
    unsigned* bar; unsigned x;
    volatile LAS unsigned* st;
};

__device__ __forceinline__ XcdBarrier xcd_barrier_post(unsigned* bar, volatile LAS unsigned* st) {
    XcdBarrier b; b.bar = bar; b.x = xb_xcc_id(); b.st = st;
    if (threadIdx.x == 0) (void)xb_add(&bar[XB_XCNT(b.x)], 1u);
    return b;
}
__device__ __forceinline__ void xcd_barrier_complete(unsigned* bar, unsigned x, unsigned& nloc, unsigned& nx) {
    const unsigned G = gridDim.x * gridDim.y * gridDim.z;
    unsigned sum, cnt, mine, sp = 0u;
    for (;;) {
        sum = 0u; cnt = 0u; mine = 0u;
#pragma unroll
        for (unsigned j = 0; j < 16; ++j) { const unsigned c = xb_ld(&bar[XB_XCNT(j)]); sum += c; cnt += (c > 0u) ? 1u : 0u; mine = (j == x) ? c : mine; }
        if (sum == G) break;
        __builtin_amdgcn_s_sleep(1);
        if ((++sp & 255u) == 0u) { if (xb_ld(&bar[XB_TMO])) break; if (sp > XB_SPIN_CAP) { atomicAdd(&bar[XB_TMO], 1u); break; } }
    }
    nloc = mine > 0u ? mine : 1u; nx = cnt > 0u ? cnt : 1u;
}

__device__ __forceinline__ void xcd_barrier(const XcdBarrier& b) {
    asm volatile("s_waitcnt vmcnt(0)" ::: "memory");
    __syncthreads();
    if (threadIdx.x == 0) {
        unsigned* bar = b.bar;
        __builtin_amdgcn_s_waitcnt(0);
        unsigned nloc = b.st[0], nx = b.st[1];
        if (nloc == 0u) { xcd_barrier_complete(bar, b.x, nloc, nx); b.st[0] = nloc; b.st[1] = nx; }
        const unsigned old = xb_add(&bar[XB_XSUB(b.x)], 1u);
        const unsigned gen = old / nloc;
        if (old + 1u == (gen + 1u) * nloc) {
            __builtin_amdgcn_fence(__ATOMIC_RELEASE, "agent");
            asm volatile("s_waitcnt vmcnt(0)" ::: "memory");
            const unsigned og = xb_add(&bar[XB_TOP], 1u);
            const unsigned tg = og / nx;
            if (og + 1u == (tg + 1u) * nx) xb_add(&bar[XB_TOPGEN], 1u);
            else XB_SPIN(xb_ld(&bar[XB_TOPGEN]) == tg, bar);
            __builtin_amdgcn_fence(__ATOMIC_ACQUIRE, "agent");
            xb_add(&bar[XB_XGEN(b.x)], 1u);
            asm volatile("s_waitcnt vmcnt(0)" ::: "memory");
        } else {
            XB_SPIN(xb_ld(&bar[XB_XGEN(b.x)]) == gen, bar);
            __builtin_amdgcn_fence(__ATOMIC_ACQUIRE, "agent");
            asm volatile("s_waitcnt vmcnt(0)" ::: "memory");
        }
    }
    __syncthreads();
}

struct Args { const float* in[19]; float* out; unsigned char* ws; };

__device__ __forceinline__ float wave_sum(float v) {
#pragma unroll
    for (int o = 1; o < 64; o <<= 1) v += __shfl_xor(v, o);
    return v;
}
__device__ __forceinline__ float silu_f(float x) { return x * __builtin_amdgcn_rcpf(1.0f + __builtin_amdgcn_exp2f(-x * LOG2E)); }
__device__ __forceinline__ float dpp_ror1(float x)  { return __builtin_bit_cast(float, __builtin_amdgcn_update_dpp(0, __builtin_bit_cast(int, x), 0x121, 0xf, 0xf, false)); }
__device__ __forceinline__ float dpp_ror15(float x) { return __builtin_bit_cast(float, __builtin_amdgcn_update_dpp(0, __builtin_bit_cast(int, x), 0x12F, 0xf, 0xf, false)); }

__device__ __forceinline__ void tr_item(const float* W, int K, int N, bf16_t* WT, int k0, int src_n0, int dst_n0, LAS float* scr, int lane) {
#pragma unroll 8
    for (int i = 0; i < 32; ++i) { const int kk = 2 * i + (lane >> 5); scr[kk * 33 + (lane & 31)] = W[(size_t)(k0 + kk) * N + src_n0 + (lane & 31)]; }
    LDS_WAIT(); asm volatile("" ::: "memory");
    const int c = lane & 7;
#pragma unroll
    for (int j = 0; j < 4; ++j) { const int n = (lane >> 3) + 8 * j; const LAS float* s = scr + (8 * c) * 33 + n;
        u32x4 o; o.x = cvt_pk_bf16(s[0 * 33], s[1 * 33]); o.y = cvt_pk_bf16(s[2 * 33], s[3 * 33]); o.z = cvt_pk_bf16(s[4 * 33], s[5 * 33]); o.w = cvt_pk_bf16(s[6 * 33], s[7 * 33]);
        *(u32x4*)(WT + (size_t)(dst_n0 + n) * K + k0 + 8 * c) = o; }
    LDS_WAIT(); asm volatile("" ::: "memory");
}

__device__ __forceinline__ void prologue(const Args& a, LAS unsigned char* lds) {
    const int tid = threadIdx.x, lane = tid & 63, wave = tid >> 6;
    unsigned char* ws = a.ws;
    {
        LAS float* scr = (LAS float*)(lds + 49152 + wave * 8704);
        const int gw = blockIdx.x * 8 + wave, NGW = gridDim.x * 8;
        constexpr int I_IN = 16 * 64, I_OUT = 16 * 32, I_UP = 16 * 176, I_DN = 44 * 32, I_L = I_IN + I_OUT + I_UP + I_DN;
        for (int it = gw; it < DEPTH * I_L; it += NGW) {
            const int l = it / I_L; int r = it % I_L;
            if (r < I_IN) { const int kb = r / 64, nb = r % 64, pn = nb >> 3, p0 = (nb & 7) * 32;
                const int src = 256 * pn + 64 * ((p0 & 127) >> 5) + 32 * (p0 >> 7);
                tr_item(a.in[8] + (size_t)l * DM * DPROJ, DM, DPROJ, (bf16_t*)(ws + WS_WIN) + (size_t)l * DPROJ * DM, kb * 64, src, nb * 32, scr, lane); continue; }
            r -= I_IN;
            if (r < I_OUT) { const int kb = r / 32, nb = r % 32;
                tr_item(a.in[13] + (size_t)l * DM * DM, DM, DM, (bf16_t*)(ws + WS_WOUT) + (size_t)l * DM * DM, kb * 64, nb * 32, nb * 32, scr, lane); continue; }
            r -= I_OUT;
            if (r < I_UP) { const int kb = r / 176, nb = r % 176, pn = nb >> 3, p0 = (nb & 7) * 32;
                const int src = p0 < 128 ? 128 * pn + p0 : DFF + 128 * pn + p0 - 128;
                tr_item(a.in[14] + (size_t)l * DM * 2 * DFF, DM, 2 * DFF, (bf16_t*)(ws + WS_WUP) + (size_t)l * 2 * DFF * DM, kb * 64, src, nb * 32, scr, lane); continue; }
            r -= I_UP;
            { const int kb = r / 32, nb = r % 32;
                tr_item(a.in[17] + (size_t)l * DFF * DM, DFF, DM, (bf16_t*)(ws + WS_WDN) + (size_t)l * DM * DFF, kb * 64, nb * 32, nb * 32, scr, lane); }
        }
    }
    {
        float* cosT = (float*)(ws + WS_ROPE); float* sinT = cosT + SEQ * 32;
        for (int idx = blockIdx.x * 512 + tid; idx < SEQ * 32; idx += gridDim.x * 512) {
            const int t = idx >> 5, i = idx & 31, p = i & 15, pa = p >> 2, pb = p & 3;
            const int pos = i < 16 ? (t >> 6) : (t & 63);
            const double ia = pa == 0 ? 1.0 : pa == 1 ? 0.1 : pa == 2 ? 0.01 : 0.001;
            const double ib = pb == 0 ? 1.0 : pb == 1 ? 0.5623413251903491 : pb == 2 ? 0.31622776601683794 : 0.17782794100389228;
            const double x = (double)pos * (ia * ib);
            const double kq = __builtin_rint(x * 0.6366197723675814);
            const double r = (x - kq * 1.5707963267948966) - kq * 6.123233995736766e-17;
            const double r2 = r * r;
            const double sn = r * (1.0 + r2 * (-1.0 / 6 + r2 * (1.0 / 120 + r2 * (-1.0 / 5040 + r2 * (1.0 / 362880 + r2 * (-1.0 / 39916800 + r2 * (1.0 / 6227020800.0)))))));
            const double cs = 1.0 + r2 * (-0.5 + r2 * (1.0 / 24 + r2 * (-1.0 / 720 + r2 * (1.0 / 40320 + r2 * (-1.0 / 3628800 + r2 * (1.0 / 479001600 + r2 * (-1.0 / 87178291200.0)))))));
            const int q = ((int)kq) & 3;
            const double c = q == 0 ? cs : q == 1 ? -sn : q == 2 ? -cs : sn;
            const double s = q == 0 ? sn : q == 1 ? cs : q == 2 ? -sn : -cs;
            cosT[idx] = (float)c; sinT[idx] = (float)s;
        }
    }
    if (blockIdx.x == 0) { float* gains = (float*)(ws + WS_GAIN); const int l = tid >> 7, w = (tid >> 6) & 1, d = tid & 63; gains[tid] = w ? a.in[10][l * 64 + d] : a.in[9][l * 64 + d];
        if (tid < DEPTH) { float mq = 0.f, mk = 0.f; for (int d2 = 0; d2 < 64; ++d2) { mq = fmaxf(mq, fabsf(a.in[9][tid * 64 + d2])); mk = fmaxf(mk, fabsf(a.in[10][tid * 64 + d2])); }
            gains[512 + tid] = 64.0f * mq * mk * QSCALE * 1.02f; } }
    { float* cp = (float*)(ws + WS_CP); const int gt = blockIdx.x * 512 + tid, NT = gridDim.x * 512;
      for (int i = gt; i < 4096; i += NT) { cp[CP_AN + i] = a.in[4][i]; cp[CP_FN + i] = a.in[5][i]; }
      for (int i = gt; i < 7440; i += NT) cp[CP_RPB + i] = a.in[11][i];
      for (int i = gt; i < 16; i += NT) cp[CP_SINK + i] = a.in[12][i];
      for (int i = gt; i < 1024; i += NT) cp[CP_FIN + i] = a.in[18][i];
      for (int i = gt; i < DEPTH * 4 * DFF; i += NT) { const int l = i / (4 * DFF), r = i % (4 * DFF); cp[CP_CONV + i] = r < 3 * DFF ? a.in[15][l * 3 * DFF + r] : a.in[16][l * DFF + r - 3 * DFF]; } }
    {
        LAS float* ca = (LAS float*)lds;
        LAS float* red = (LAS float*)(lds + 36864);
        for (int idx = tid; idx < 9 * DM; idx += 512) { const int r = idx >> 10, k = idx & 1023; const float v = r < 8 ? a.in[1][r * DM + k] : a.in[3][k]; ca[idx] = v / (1.0f + expf(-v)); }
        __syncthreads();
        float* mod = (float*)(ws + WS_MOD);
        const int c4 = lane & 7, kr = lane >> 3;
        for (int item = blockIdx.x; item < DEPTH * 192; item += gridDim.x) {
            const int l = item / 192, col0 = (item % 192) * 32;
            f32x4 acc[9];
#pragma unroll
            for (int r = 0; r < 9; ++r) acc[r] = (f32x4){0.f, 0.f, 0.f, 0.f};
            const float* wp = a.in[6] + ((size_t)l * DM + wave * 128 + kr) * NMOD + col0 + 4 * c4;
#pragma unroll 4
            for (int i = 0; i < 16; ++i) { const f32x4 wv = *(const f32x4*)(wp + (size_t)i * 8 * NMOD); const int k = wave * 128 + 8 * i + kr;
#pragma unroll
                for (int r = 0; r < 9; ++r) acc[r] += ca[r * DM + k] * wv; }
#pragma unroll
            for (int r = 0; r < 9; ++r)
#pragma unroll
                for (int j = 0; j < 4; ++j) { float v = acc[r][j]; v += __shfl_xor(v, 8); v += __shfl_xor(v, 16); v += __shfl_xor(v, 32); acc[r][j] = v; }
            if (kr == 0) {
#pragma unroll
                for (int r = 0; r < 9; ++r) *(LAS f32x4*)(red + (wave * 9 + r) * 32 + 4 * c4) = acc[r]; }
            __syncthreads();
            if (tid < 288) { const int r = tid >> 5, ci = tid & 31; float s = a.in[7][l * NMOD + col0 + ci];
#pragma unroll
                for (int w = 0; w < 8; ++w) s += red[(w * 9 + r) * 32 + ci];
                mod[((size_t)l * 9 + r) * NMOD + col0 + ci] = s; }
            __syncthreads();
        }
    }
}

__device__ __forceinline__ void norm_phase(const float* srcL, const float* srcC, float* xcopy, const float* g, const float* modl, int shoff, int scoff, bf16_t* H, int nrows, const bf16_t* PB = nullptr) {
    int tid_l = threadIdx.x; asm volatile("" : "+v"(tid_l));
    const int lane = tid_l & 63, wave = tid_l >> 6;
    const int gw = blockIdx.x * 8 + wave, NGW = gridDim.x * 8;
    for (int row = gw; row < nrows; row += NGW) {
        const float* src = row < ML ? srcL + (size_t)row * DM : srcC + (size_t)(row - ML) * DM;
        const int bidx = row < ML ? row >> 11 : 8;
        const float* mr = modl + (size_t)bidx * NMOD;
        f32x4 v[4]; float ss = 0.f;
#pragma unroll
        for (int j = 0; j < 4; ++j) { v[j] = *(const f32x4*)(src + 4 * (64 * j + lane));
            if (PB && row >= ML) { const size_t o = (size_t)(row - ML) * DM + 4 * (64 * j + lane);
#pragma unroll
                for (int sl = 0; sl < 4; ++sl) { const u32x2 w = *(const u32x2*)(PB + (size_t)sl * MC * DM + o);
                    v[j].x += __uint_as_float(w.x << 16); v[j].y += __uint_as_float(w.x & 0xffff0000u); v[j].z += __uint_as_float(w.y << 16); v[j].w += __uint_as_float(w.y & 0xffff0000u); }
                *(f32x4*)(const_cast<float*>(src) + 4 * (64 * j + lane)) = v[j]; }
            ss += (v[j].x * v[j].x + v[j].y * v[j].y) + (v[j].z * v[j].z + v[j].w * v[j].w); }
        const float rstd = 1.0f / sqrtf(wave_sum(ss) * (1.0f / DM) + EPS);
#pragma unroll
        for (int j = 0; j < 4; ++j) { const int c = 4 * (64 * j + lane);
            const f32x4 gv = *(const f32x4*)(g + c), sc = *(const f32x4*)(mr + scoff + c), sh = *(const f32x4*)(mr + shoff + c);
            const f32x4 y = (v[j] * rstd) * gv * (1.0f + sc) + sh;
            u32x2 o; o.x = cvt_pk_bf16(y.x, y.y); o.y = cvt_pk_bf16(y.z, y.w);
            *(u32x2*)(H + (size_t)row * DM + c) = o;
            if (xcopy && (row >= ML || gridDim.x != 256)) *(f32x4*)(xcopy + (size_t)row * DM + c) = v[j]; }
    }
}
__device__ __forceinline__ void final_norm_phase(const float* X, const float* g, float* out) {
    const int lane = threadIdx.x & 63, wave = threadIdx.x >> 6;
    const int gw = blockIdx.x * 8 + wave, NGW = gridDim.x * 8;
    for (int row = gw; row < ML; row += NGW) {
        const float* src = X + (size_t)row * DM;
        f32x4 v[4]; float ss = 0.f;
#pragma unroll
        for (int j = 0; j < 4; ++j) { v[j] = *(const f32x4*)(src + 4 * (64 * j + lane)); ss += (v[j].x * v[j].x + v[j].y * v[j].y) + (v[j].z * v[j].z + v[j].w * v[j].w); }
        const float rstd = 1.0f / sqrtf(wave_sum(ss) * (1.0f / DM) + EPS);
#pragma unroll
        for (int j = 0; j < 4; ++j) { const int c = 4 * (64 * j + lane); const f32x4 gv = *(const f32x4*)(g + c);
            *(f32x4*)(out + (size_t)row * DM + c) = (v[j] * rstd) * gv; }
    }
}

struct EpiQKV {
    static constexpr bool PERM = true, AFTER_DRAIN = false;
    bf16_t* Q; bf16_t* Kf; bf16_t* Vf; const float* gains; const float* cosT; const float* sinT;
    __device__ __forceinline__ void operator()(const pg8::f32x4 (&acc)[2][2][4][2], const pg8::Unit& u, int wr_, int wc_, int fr_, int fq_) const {
        int wr = wr_, wc = wc_, fr = fr_, fq = fq_; asm volatile("" : "+s"(wr), "+s"(wc), "+v"(fr), "+v"(fq));
        const int pn = u.pn, pm = u.pm;
        int kind = 0, head = 0, nrm = 0, rope = 0;
        if (pn == 0) { kind = 0; head = wc; }
        else if (pn == 1) { kind = 1; head = wc; }
        else if (pn == 2) { kind = 2; head = wc; }
        else if (pn == 3 || pn == 4) { kind = 0; head = 4 * (pn - 2) + wc; nrm = 1; rope = 1; }
        else if (pn == 5) { if (wc < 2) { kind = 1; head = 4 + wc; nrm = 2; rope = 1; } else { kind = 2; head = 2 + wc; } }
        else if (pn == 6) { kind = 0; head = 12 + wc; rope = 1; }
        else { if (wc < 2) { kind = 1; head = 6 + wc; rope = 1; } else { kind = 2; head = 4 + wc; } }
        const bool latent = pm < 64;
        const int b = latent ? (pm >> 3) : (pm - 64);
        const int tile0 = latent ? (pm & 7) * 4 : 32;
        const int s0 = latent ? (pm & 7) * 256 : 0;
        if (!latent) rope = 0;
        const float* gp = gains + (nrm == 2 ? 64 : 0) + 8 * fq;
#pragma unroll
        for (int ai = 0; ai < 2; ++ai)
#pragma unroll
            for (int m = 0; m < 4; ++m) {
                const int rl = 128 * ai + 64 * wr + 16 * m + fr;
                f32x4 v[2][2];
#pragma unroll
                for (int bj = 0; bj < 2; ++bj)
#pragma unroll
                    for (int n = 0; n < 2; ++n) v[bj][n] = acc[ai][bj][m][n];
                if (nrm) {
                    float ss = 0.f;
#pragma unroll
                    for (int bj = 0; bj < 2; ++bj)
#pragma unroll
                        for (int n = 0; n < 2; ++n) ss += (v[bj][n].x * v[bj][n].x + v[bj][n].y * v[bj][n].y) + (v[bj][n].z * v[bj][n].z + v[bj][n].w * v[bj][n].w);
                    ss += __shfl_xor(ss, 16); ss += __shfl_xor(ss, 32);
                    const float rs = 1.0f / sqrtf(ss * (1.0f / 64.0f) + EPS);
#pragma unroll
                    for (int bj = 0; bj < 2; ++bj)
#pragma unroll
                        for (int n = 0; n < 2; ++n) v[bj][n] = (v[bj][n] * rs) * *(const f32x4*)(gp + 32 * bj + 4 * n);
                }
                if (rope) {
                    const int s = s0 + rl;
#pragma unroll
                    for (int n = 0; n < 2; ++n) {
                        const f32x4 cs = *(const f32x4*)(cosT + s * 32 + 8 * fq + 4 * n), sn = *(const f32x4*)(sinT + s * 32 + 8 * fq + 4 * n);
                        const f32x4 x1 = v[0][n], x2 = v[1][n];
                        v[0][n] = x1 * cs - x2 * sn; v[1][n] = x1 * sn + x2 * cs; }
                }
                if (kind == 0) {
#pragma unroll
                    for (int bj = 0; bj < 2; ++bj) { const f32x4 a0 = v[bj][0] * QSCALE, a1 = v[bj][1] * QSCALE;
                        u32x4 w; w.x = cvt_pk_bf16(a0.x, a0.y); w.y = cvt_pk_bf16(a0.z, a0.w); w.z = cvt_pk_bf16(a1.x, a1.y); w.w = cvt_pk_bf16(a1.z, a1.w);
                        *(u32x4*)(Q + (size_t)(pm * 256 + rl) * DM + head * 64 + bj * 32 + 8 * fq) = w; }
                } else if (kind == 1) {
                    bf16_t* base = Kf + ((size_t)((b * 8 + head) * KT + tile0 + 2 * ai + wr)) * 4096;
                    const int kblk = m >> 1, r32 = 16 * (m & 1) + fr;
#pragma unroll
                    for (int bj = 0; bj < 2; ++bj) { const int d0 = 2 * bj + (fq >> 1), hi = fq & 1;
                        u32x4 w; w.x = cvt_pk_bf16(v[bj][0].x, v[bj][0].y); w.y = cvt_pk_bf16(v[bj][0].z, v[bj][0].w); w.z = cvt_pk_bf16(v[bj][1].x, v[bj][1].y); w.w = cvt_pk_bf16(v[bj][1].z, v[bj][1].w);
                        *(u32x4*)(base + ((kblk * 4 + d0) * 64 + hi * 32 + r32) * 8) = w; }
                } else {
                    bf16_t* base = Vf + ((size_t)((b * 8 + head) * KT + tile0 + 2 * ai + wr)) * 4096;
#pragma unroll
                    for (int bj = 0; bj < 2; ++bj) {
                        u32x4 w; w.x = cvt_pk_bf16(v[bj][0].x, v[bj][0].y); w.y = cvt_pk_bf16(v[bj][0].z, v[bj][0].w); w.z = cvt_pk_bf16(v[bj][1].x, v[bj][1].y); w.w = cvt_pk_bf16(v[bj][1].z, v[bj][1].w);
                        *(u32x4*)(base + ((4 * m + (fr >> 2)) * 4 + 2 * bj + (fq >> 1)) * 64 + (fr & 3) * 16 + (fq & 1) * 8) = w; }
                }
                if (m & 1) asm volatile("" ::: "memory");
            }
    }
};

struct EpiRes {
    static constexpr bool PERM = false, AFTER_DRAIN = false;
    float* X; const float* Xin; const float* modl; int goff; bf16_t* PB;
    __device__ __forceinline__ void operator()(const pg8::f32x4 (&acc)[2][2][4][2], const pg8::Unit& u, int wr_, int wc_, int fr_, int fq_) const {
        int wr = wr_, wc = wc_, fr = fr_, fq = fq_; asm volatile("" : "+s"(wr), "+s"(wc), "+v"(fr), "+v"(fq));
        const int bidx = u.pm < 64 ? (u.pm >> 3) : 8;
        const float* gate = modl + (size_t)bidx * NMOD + goff;
        const int c0 = u.pn * 256 + wc * 32 + 4 * fq;
        f32x4 gv[2][2];
#pragma unroll
        for (int bj = 0; bj < 2; ++bj)
#pragma unroll
            for (int n = 0; n < 2; ++n) gv[bj][n] = *(const f32x4*)(gate + c0 + 128 * bj + 16 * n);
        if (u.part) {
            bf16_t* pb = PB + (size_t)(u.part - 1) * MC * DM;
#pragma unroll
            for (int ai = 0; ai < 2; ++ai)
#pragma unroll
                for (int m = 0; m < 4; ++m) { bf16_t* pr = pb + (size_t)((u.pm - 64) * 256 + 128 * ai + 64 * wr + 16 * m + fr) * DM + c0;
#pragma unroll
                    for (int bj = 0; bj < 2; ++bj)
#pragma unroll
                        for (int n = 0; n < 2; ++n) { const f32x4 v = gv[bj][n] * acc[ai][bj][m][n]; u32x2 o; o.x = cvt_pk_bf16(v.x, v.y); o.y = cvt_pk_bf16(v.z, v.w); *(u32x2*)(pr + 128 * bj + 16 * n) = o; } }
            return;
        }
#pragma unroll
        for (int ai = 0; ai < 2; ++ai)
#pragma unroll
            for (int m = 0; m < 4; ++m) { const size_t ro = (size_t)(u.pm * 256 + 128 * ai + 64 * wr + 16 * m + fr) * DM + c0; float* xr = X + ro; const float* xi = Xin + ro;
#pragma unroll
                for (int bj = 0; bj < 2; ++bj)
#pragma unroll
                    for (int n = 0; n < 2; ++n) { *(f32x4*)(xr + 128 * bj + 16 * n) = *(const f32x4*)(xi + 128 * bj + 16 * n) + gv[bj][n] * acc[ai][bj][m][n]; }
                if (m & 1) asm volatile("" ::: "memory"); }

    }
};

struct EpiUp {
    static constexpr bool PERM = true, AFTER_DRAIN = false;
    bf16_t* HID; float* EDGE; const float* cw; const float* cb;
    __device__ __forceinline__ void operator()(const pg8::f32x4 (&acc)[2][2][4][2], const pg8::Unit& u, int wr_, int wc_, int fr_, int fq_) const {
        int wr = wr_, wc = wc_, fr = fr_, fq = fq_; asm volatile("" : "+s"(wr), "+s"(wc), "+v"(fr), "+v"(fq));
        const int col0 = 128 * u.pn + 32 * wc + 8 * fq;
        f32x4 w0[2], w1[2], w2[2], bb[2];
#pragma unroll
        for (int n = 0; n < 2; ++n) { w0[n] = *(const f32x4*)(cw + col0 + 4 * n); w1[n] = *(const f32x4*)(cw + DFF + col0 + 4 * n); w2[n] = *(const f32x4*)(cw + 2 * DFF + col0 + 4 * n); bb[n] = *(const f32x4*)(cb + col0 + 4 * n); }
#pragma unroll
        for (int ai = 0; ai < 2; ++ai) {
            const int g = u.pm * 4 + 2 * ai + wr;
#pragma unroll
            for (int m = 0; m < 4; ++m) {
                const int row = u.pm * 256 + 128 * ai + 64 * wr + 16 * m + fr;
                f32x4 cv[2];
#pragma unroll
                for (int n = 0; n < 2; ++n) {
                    const f32x4 av = acc[ai][0][m][n];
                    f32x4 pv, nv;
#pragma unroll
                    for (int j = 0; j < 4; ++j) {
                        const float p1 = dpp_ror1(av[j]); const float p2 = m > 0 ? dpp_ror1(acc[ai][0][m > 0 ? m - 1 : 0][n][j]) : 0.f;
                        pv[j] = fr == 0 ? p2 : p1;
                        const float n1 = dpp_ror15(av[j]); const float n2 = m < 3 ? dpp_ror15(acc[ai][0][m < 3 ? m + 1 : 3][n][j]) : 0.f;
                        nv[j] = fr == 15 ? n2 : n1; }
                    cv[n] = w1[n] * av + bb[n] + w0[n] * pv + w2[n] * nv;
                }
                const bool first = (m == 0 && fr == 0), lastr = (m == 3 && fr == 15);
                if (first || lastr) {
                    float* e = EDGE + ((size_t)(g * 2 + (lastr ? 1 : 0)) * 3) * DFF + col0;
#pragma unroll
                    for (int n = 0; n < 2; ++n) { *(f32x4*)(e + 4 * n) = acc[ai][0][m][n]; *(f32x4*)(e + DFF + 4 * n) = cv[n]; *(f32x4*)(e + 2 * DFF + 4 * n) = acc[ai][1][m][n]; }
                } else {
                    f32x4 h0, h1;
#pragma unroll
                    for (int j = 0; j < 4; ++j) { h0[j] = silu_f(cv[0][j]) * acc[ai][1][m][0][j]; h1[j] = silu_f(cv[1][j]) * acc[ai][1][m][1][j]; }
                    u32x4 w; w.x = cvt_pk_bf16(h0.x, h0.y); w.y = cvt_pk_bf16(h0.z, h0.w); w.z = cvt_pk_bf16(h1.x, h1.y); w.w = cvt_pk_bf16(h1.z, h1.w);
                    __builtin_nontemporal_store(w, (u32x4*)(HID + (size_t)row * DFF + col0));
                }
            }
        }
    }
};

__device__ __forceinline__ void fixup_phase(const float* EDGE, const float* cw, bf16_t* HID, int ngroups) {
    const int total = ngroups * 2 * (DFF / 4);
    for (int idx = blockIdx.x * 512 + threadIdx.x; idx < total; idx += gridDim.x * 512) {
        const int c4 = idx % (DFF / 4), gw = idx / (DFF / 4), which = gw & 1, g = gw >> 1, col = 4 * c4;
        const int seqg = g < 256 ? 32 : 4;
        const float* e = EDGE + ((size_t)(g * 2 + which) * 3) * DFF + col;
        f32x4 part = *(const f32x4*)(e + DFF); const f32x4 bv = *(const f32x4*)(e + 2 * DFF);
        if (which == 0) { if (g % seqg != 0) part += *(const f32x4*)(cw + col) * *(const f32x4*)(EDGE + ((size_t)((g - 1) * 2 + 1) * 3) * DFF + col); }
        else { if ((g + 1) % seqg != 0) part += *(const f32x4*)(cw + 2 * DFF + col) * *(const f32x4*)(EDGE + ((size_t)((g + 1) * 2) * 3) * DFF + col); }
        u32x2 o; o.x = cvt_pk_bf16(silu_f(part.x) * bv.x, silu_f(part.y) * bv.y); o.y = cvt_pk_bf16(silu_f(part.z) * bv.z, silu_f(part.w) * bv.w);
        *(u32x2*)(HID + (size_t)(64 * g + (which ? 63 : 0)) * DFF + col) = o;
    }
}

__device__ __forceinline__ void fixup_tile(const float* EDGE, const float* cw, bf16_t* HID, int g0) {
    for (int idx = threadIdx.x; idx < 4 * 2 * (DFF / 4); idx += 512) {
        const int c4 = idx % (DFF / 4), gw = idx / (DFF / 4), which = gw & 1, g = g0 + (gw >> 1), col = 4 * c4;
        const int seqg = g < 256 ? 32 : 4;
        const float* e = EDGE + ((size_t)(g * 2 + which) * 3) * DFF + col;
        f32x4 part = *(const f32x4*)(e + DFF); const f32x4 bv = *(const f32x4*)(e + 2 * DFF);
        if (which == 0) { if (g % seqg != 0) part += *(const f32x4*)(cw + col) * *(const f32x4*)(EDGE + ((size_t)((g - 1) * 2 + 1) * 3) * DFF + col); }
        else { if ((g + 1) % seqg != 0) part += *(const f32x4*)(cw + 2 * DFF + col) * *(const f32x4*)(EDGE + ((size_t)((g + 1) * 2) * 3) * DFF + col); }
        u32x2 o; o.x = cvt_pk_bf16(silu_f(part.x) * bv.x, silu_f(part.y) * bv.y); o.y = cvt_pk_bf16(silu_f(part.z) * bv.z, silu_f(part.w) * bv.w);
        *(u32x2*)(HID + (size_t)(64 * g + (which ? 63 : 0)) * DFF + col) = o;
    }
}

struct AttnP { const bf16_t* Q; bf16_t* O; const bf16_t* Kf; const bf16_t* Vf; const float* rpb; const float* sink; unsigned* counter; int nunits; float bbound; unsigned* xq; };

typedef short v4i16_t __attribute__((ext_vector_type(4)));
typedef float f32x2 __attribute__((ext_vector_type(2)));
__device__ __forceinline__ float half_max(float m) { auto rr = __builtin_amdgcn_permlane32_swap(__float_as_uint(m), __float_as_uint(m), false, false); return fmaxf(__uint_as_float(rr[0]), __uint_as_float(rr[1])); }
__device__ __forceinline__ float half_sum(float m) { auto rr = __builtin_amdgcn_permlane32_swap(__float_as_uint(m), __float_as_uint(m), false, false); return __uint_as_float(rr[0]) + __uint_as_float(rr[1]); }
#define MX3(a, b, c) __builtin_fmaxf(__builtin_fmaxf((a), (b)), (c))

__device__ __forceinline__ void glds16(const void* gsrc, unsigned lds_dst) { unsigned keep;
    asm volatile("s_mov_b32 %0, m0\n\ts_mov_b32 m0, %2\n\ts_nop 0\n\tglobal_load_lds_dwordx4 %1, off\n\ts_mov_b32 m0, %0" : "=&s"(keep) : "v"(gsrc), "s"(lds_dst) : "memory"); }
template <int MODE, bool NM = false> __device__ __forceinline__ void attn_unit(LAS unsigned char* lds, const AttnP& P, int b, int qhead, int kvh, int qpos0, int qrow0, int tlo, int thi, int sinkidx) {
    int tid_l = threadIdx.x; asm volatile("" : "+v"(tid_l));
    const int tid = tid_l, lane = tid & 63, wid = __builtin_amdgcn_readfirstlane(tid >> 6), r32 = lane & 31, hi = lane >> 5;
    constexpr int RM = 7;
    LAS unsigned char* ldsK = lds; LAS unsigned char* ldsV = lds + 65536;
    LAS float* tab = (LAS float*)(lds + 131072 + 512);
    const unsigned ldsK0 = (unsigned)(size_t)ldsK, ldsV0 = (unsigned)(size_t)ldsV;
    const int vlane = hi * 512 + ((lane >> 4) & 1) * 128 + ((lane & 15) >> 2) * 32 + (lane & 3) * 8;
    constexpr float THR = 8.0f;
    {
        const int nsteps = 4 + (thi - tlo);
        const bf16_t* kbase = P.Kf + (size_t)((b * 8 + kvh) * KT) * 4096 + tid * 8;
        const bf16_t* vbase = P.Vf + (size_t)((b * 8 + kvh) * KT) * 4096 + tid * 8;
        bf16x8 qf[4];
        { const bf16_t* qp = P.Q + (size_t)(qrow0 + wid * 32 + r32) * DM + qhead * 64 + hi * 8;
#pragma unroll
          for (int d0 = 0; d0 < 4; ++d0) qf[d0] = *(const bf16x8*)(qp + d0 * 16); }
        if (MODE == 1) { for (int i = tid; i < 15 * 31; i += 512) tab[i] = P.rpb[qhead * 465 + i] * LOG2E; }
        const int qw0 = qpos0 + wid * 32;
        const int qpos = qw0 + r32;
        float mref = 0.f, lrun = 0.f;
        f32x16 o0, o1, negm;
#pragma unroll
        for (int i = 0; i < 16; ++i) { o0[i] = 0.f; o1[i] = 0.f; negm[i] = 0.f; }
#define ATT_TILE(s_) ((s_) < 4 ? 32 + (s_) : tlo + (s_) - 4)
#define ATT_DMA(s_) do { const int tt_ = ATT_TILE(s_); const unsigned sl_ = (unsigned)(((s_) & RM) * 8192 + wid * 1024); \
            glds16(kbase + (size_t)tt_ * 4096, (unsigned)__builtin_amdgcn_readfirstlane(ldsK0 + sl_)); \
            glds16(vbase + (size_t)tt_ * 4096, (unsigned)__builtin_amdgcn_readfirstlane(ldsV0 + sl_)); } while (0)
        ATT_DMA(0); ATT_DMA(1); ATT_DMA(2);
        ATT_DMA(3);
        asm volatile("s_waitcnt vmcnt(0)" : "+v"(qf[0]), "+v"(qf[1]), "+v"(qf[2]), "+v"(qf[3]) :: "memory");
        for (int st = 0; st < nsteps; ++st) {
            if ((st & 3) == 0) {
                asm volatile("s_waitcnt vmcnt(0)" ::: "memory");
                asm volatile("s_waitcnt lgkmcnt(0)" ::: "memory");
                __builtin_amdgcn_s_barrier();
                asm volatile("" ::: "memory");
                if (st + 4 < nsteps) ATT_DMA(st + 4);
                if (st + 5 < nsteps) ATT_DMA(st + 5);
                if (st + 6 < nsteps) ATT_DMA(st + 6);
                if (st + 7 < nsteps) ATT_DMA(st + 7); }
            const int t = ATT_TILE(st);
            const int buf = st & RM;
            bool skip = false;
            if (st >= 4) {
                if (MODE == 1) { const int qr = qw0 >> 6, rs = min(max(qr - 4, 0), 24); skip = (t < rs) || (t >= rs + 8); }
                else if (MODE == 2) { skip = (64 * t > qw0 + 31 + 128) || (64 * t + 63 < qw0 - 128); }
            }
            if (!skip) {
            const LAS unsigned char* kb = ldsK + buf * 8192 + lane * 16;
            const LAS unsigned char* vb = ldsV + buf * 8192 + vlane;
            f32x16 s0, s1;
            {
                bf16x8 kf[8];
#pragma unroll
                for (int i = 0; i < 8; ++i) kf[i] = *(const LAS bf16x8*)(kb + i * 1024);
                __builtin_amdgcn_sched_barrier(0);
                if (NM) { const f32x16 z = {0.f, 0.f, 0.f, 0.f, 0.f, 0.f, 0.f, 0.f, 0.f, 0.f, 0.f, 0.f, 0.f, 0.f, 0.f, 0.f};
                    s0 = __builtin_amdgcn_mfma_f32_32x32x16_bf16(kf[0], qf[0], z, 0, 0, 0); s1 = __builtin_amdgcn_mfma_f32_32x32x16_bf16(kf[4], qf[0], z, 0, 0, 0); }
                else { s0 = __builtin_amdgcn_mfma_f32_32x32x16_bf16(kf[0], qf[0], negm, 0, 0, 0); s1 = __builtin_amdgcn_mfma_f32_32x32x16_bf16(kf[4], qf[0], negm, 0, 0, 0); }
#pragma unroll
                for (int d0 = 1; d0 < 4; ++d0) { s0 = __builtin_amdgcn_mfma_f32_32x32x16_bf16(kf[d0], qf[d0], s0, 0, 0, 0); s1 = __builtin_amdgcn_mfma_f32_32x32x16_bf16(kf[4 + d0], qf[d0], s1, 0, 0, 0); }
                __builtin_amdgcn_sched_barrier(0);
            }
            v4i16_t vlo[8], vhi[8];
#pragma unroll
            for (int i = 0; i < 8; ++i) { vlo[i] = __builtin_amdgcn_ds_read_tr16_b64_v4i16((LAS v4i16_t*)(vb + (i & 3) * 2048 + (i >> 2) * 256));
                                          vhi[i] = __builtin_amdgcn_ds_read_tr16_b64_v4i16((LAS v4i16_t*)(vb + (i & 3) * 2048 + (i >> 2) * 256 + 1024)); }
            __builtin_amdgcn_sched_barrier(0);
            if (st >= 4) {
                if (MODE == 2 && !((64 * t >= qw0 + 31 - 128) && (64 * t + 63 <= qw0 + 128))) {
                    const int base = qpos - 64 * t - 4 * hi;
#pragma unroll
                    for (int i = 0; i < 16; ++i) { const int d = base - ((i & 3) + 8 * (i >> 2));
                        if (d > 128 || d < -128) s0[i] = NEGBIG;
                        if (d - 32 > 128 || d - 32 < -128) s1[i] = NEGBIG;
                        if ((i & 3) == 3) asm volatile("" : "+v"(s0), "+v"(s1)); }
                } else if (MODE == 1) {
                    const int qr = qpos >> 6, qc = qpos & 63;
                    const int cs = min(max(qc - 8, 0), 48);
                    const int tb = (t - qr + 7) * 31 + 15 - qc;
#pragma unroll
                    for (int i = 0; i < 16; ++i) { const int kk = 4 * hi + (i & 3) + 8 * (i >> 2);
                        const bool ok0 = kk >= cs && kk < cs + 16;
                        const bool ok1 = kk + 32 >= cs && kk + 32 < cs + 16;
                        int i0_ = ok0 ? tb + kk : 0, i1_ = ok1 ? tb + kk + 32 : 0; asm volatile("" : "+v"(i0_), "+v"(i1_));
                        const float b0 = tab[i0_], b1 = tab[i1_];
                        s0[i] = ok0 ? s0[i] + b0 : NEGBIG; s1[i] = ok1 ? s1[i] + b1 : NEGBIG;
                        if ((i & 3) == 3) asm volatile("" ::: "memory"); }
                }
            }
            if (!NM) {
            float ma = MX3(s0[0], s0[1], s1[0]), mb = MX3(s0[2], s0[3], s1[1]); ma = MX3(ma, s1[2], s1[3]);
#pragma unroll
            for (int r = 4; r < 16; r += 4) { ma = MX3(ma, s0[r], s0[r + 1]); mb = MX3(mb, s0[r + 2], s0[r + 3]); ma = MX3(ma, s1[r], s1[r + 1]); mb = MX3(mb, s1[r + 2], s1[r + 3]); }
            const float mx = half_max(fmaxf(ma, mb));
            if (st == 0) {
                mref = mx;
#pragma unroll
                for (int i = 0; i < 16; ++i) { s0[i] -= mx; s1[i] -= mx; negm[i] = -mx; }
            } else if (__any(mx > THR)) {
                const float dl = fmaxf(mx, 0.f); mref += dl;
                const float f = __builtin_amdgcn_exp2f(-dl); lrun *= f;
#pragma unroll
                for (int i = 0; i < 16; ++i) { s0[i] -= dl; s1[i] -= dl; negm[i] = -mref; o0[i] *= f; o1[i] *= f; }
            }
            }
            float lsa = 0.f, lsb = 0.f;
#pragma unroll
            for (int i = 0; i < 16; i += 2) { s0[i] = __builtin_amdgcn_exp2f(s0[i]); s0[i + 1] = __builtin_amdgcn_exp2f(s0[i + 1]); s1[i] = __builtin_amdgcn_exp2f(s1[i]); s1[i + 1] = __builtin_amdgcn_exp2f(s1[i + 1]);
                lsa += s0[i]; lsb += s0[i + 1]; asm volatile("" : "+v"(lsa), "+v"(lsb)); lsa += s1[i]; lsb += s1[i + 1]; asm volatile("" : "+v"(lsa), "+v"(lsb)); }
            lrun += lsa + lsb;
            u32x4 pw[4];
#pragma unroll
            for (int c = 0; c < 2; ++c) {
                pw[c].x = cvt_pk_bf16(s0[8 * c + 0], s0[8 * c + 1]); pw[c].y = cvt_pk_bf16(s0[8 * c + 2], s0[8 * c + 3]); pw[c].z = cvt_pk_bf16(s0[8 * c + 4], s0[8 * c + 5]); pw[c].w = cvt_pk_bf16(s0[8 * c + 6], s0[8 * c + 7]);
                pw[2 + c].x = cvt_pk_bf16(s1[8 * c + 0], s1[8 * c + 1]); pw[2 + c].y = cvt_pk_bf16(s1[8 * c + 2], s1[8 * c + 3]); pw[2 + c].z = cvt_pk_bf16(s1[8 * c + 4], s1[8 * c + 5]); pw[2 + c].w = cvt_pk_bf16(s1[8 * c + 6], s1[8 * c + 7]); }
            __builtin_amdgcn_sched_barrier(0);
#pragma unroll
            for (int c = 0; c < 4; ++c) {
                const bf16x8 v0 = (bf16x8){vlo[c][0], vlo[c][1], vlo[c][2], vlo[c][3], vhi[c][0], vhi[c][1], vhi[c][2], vhi[c][3]};
                const bf16x8 v1 = (bf16x8){vlo[4 + c][0], vlo[4 + c][1], vlo[4 + c][2], vlo[4 + c][3], vhi[4 + c][0], vhi[4 + c][1], vhi[4 + c][2], vhi[4 + c][3]};
                const bf16x8 pf = __builtin_bit_cast(bf16x8, pw[c]);
                o0 = __builtin_amdgcn_mfma_f32_32x32x16_bf16(v0, pf, o0, 0, 0, 0);
                o1 = __builtin_amdgcn_mfma_f32_32x32x16_bf16(v1, pf, o1, 0, 0, 0); }
            }
        }
        lrun = half_sum(lrun);
        if (sinkidx >= 0) lrun += __builtin_amdgcn_exp2f(P.sink[sinkidx] * LOG2E - mref);
        const float inv = 1.0f / lrun;
        bf16_t* op = P.O + (size_t)(qrow0 + wid * 32 + r32) * DM + qhead * 64 + 4 * hi;
#pragma unroll
        for (int g = 0; g < 4; ++g) {
            u32x2 w; w.x = cvt_pk_bf16(o0[4 * g] * inv, o0[4 * g + 1] * inv); w.y = cvt_pk_bf16(o0[4 * g + 2] * inv, o0[4 * g + 3] * inv);
            *(u32x2*)(op + 8 * g) = w;
            u32x2 w2; w2.x = cvt_pk_bf16(o1[4 * g] * inv, o1[4 * g + 1] * inv); w2.y = cvt_pk_bf16(o1[4 * g + 2] * inv, o1[4 * g + 3] * inv);
            *(u32x2*)(op + 32 + 8 * g) = w2; }
        __syncthreads();
    }
}

__device__ __forceinline__ void attn_phase(LAS unsigned char* lds, const AttnP P) {
    volatile LAS int* qw = (volatile LAS int*)(lds + 131072 + 128);
    const bool xcdq = (gridDim.x == 256);
    const unsigned myx = xb_xcc_id() & 7u;
    bool bdone = !xcdq;
#define ATT_FETCH(dst_) do { int r_ = -1; \
        if (!bdone) { const unsigned j_ = atomicAdd(P.xq + 8 * myx, 1u); \
            if (j_ < 64u) { const unsigned gi_ = myx + 8u * (j_ >> 5), r2_ = j_ & 31u; r_ = (int)((gi_ >> 1) * 64u + ((gi_ & 1u) * 4u + (r2_ >> 3)) * 8u + (r2_ & 7u)); } else bdone = true; } \
        if (r_ < 0) r_ = (xcdq ? 512 : 0) + (int)atomicAdd(P.counter, 1u); \
        dst_ = r_; } while (0)
    int nxt = 0;
    if (threadIdx.x == 0) ATT_FETCH(nxt);
    for (;;) {
        if (threadIdx.x == 0) qw[0] = nxt;
        __syncthreads();
        const int u = qw[0];
        if (u >= P.nunits) break;
        if (threadIdx.x == 0) ATT_FETCH(nxt);
        int mode, b, qhead, kvh, qpos0 = 0, qrow0, tlo = 0, thi = 0, sinkidx = -1;
        if (u < 512) { mode = 0; b = u >> 6; const int g = (u >> 3) & 7, qb = u & 7; qhead = 4 + g; kvh = 4 + (g >> 2); qpos0 = qb * 256; qrow0 = b * SEQ + qpos0; tlo = 0; thi = 32; }
        else if (u < 768) { const int v = u - 512; mode = 1; b = v >> 5; const int h = (v >> 3) & 3, qb = v & 7; qhead = h; kvh = h; qpos0 = qb * 256; qrow0 = b * SEQ + qpos0;
            const int r0 = 4 * qb; tlo = min(max(r0 - 4, 0), 24); thi = min(max(r0 - 1, 0), 24) + 8; }
        else if (u < 1024) { const int v = u - 768; mode = 2; b = v >> 5; const int h = (v >> 3) & 3, qb = v & 7; qhead = 12 + h; kvh = 6 + (h >> 1); qpos0 = qb * 256; qrow0 = b * SEQ + qpos0;
            tlo = max(0, 4 * qb - 2); thi = min(32, 4 * qb + 6); sinkidx = h; }
        else { const int v = u - 1024; mode = 3; b = v >> 4; qhead = v & 15; kvh = qhead < 4 ? qhead : (qhead < 12 ? 4 + ((qhead - 4) >> 2) : 6 + ((qhead - 12) >> 1)); qrow0 = ML + b * CTXL;
            if (qhead >= 12) sinkidx = qhead - 12; }
        if (mode == 1) attn_unit<1>(lds, P, b, qhead, kvh, qpos0, qrow0, tlo, thi, sinkidx);
        else if (mode == 2) attn_unit<2>(lds, P, b, qhead, kvh, qpos0, qrow0, tlo, thi, sinkidx);
        else if (P.bbound < 64.0f && qhead >= 4 && qhead < 12) attn_unit<0, true>(lds, P, b, qhead, kvh, qpos0, qrow0, tlo, thi, sinkidx);
        else attn_unit<0>(lds, P, b, qhead, kvh, qpos0, qrow0, tlo, thi, sinkidx);
    }
}

__global__ void __launch_bounds__(512, 2) mega_fwd(Args a) {
    extern __shared__ __attribute__((aligned(16))) unsigned char lds_raw[];
    LAS unsigned char* lds = (LAS unsigned char*)lds_raw;
    cg::grid_group grid = cg::this_grid();
    volatile LAS unsigned* bst = (volatile LAS unsigned*)(lds + 131072 + 64);
    if (threadIdx.x == 0) { bst[0] = 0u; bst[1] = 0u; }
    __syncthreads();
    const XcdBarrier xbar = xcd_barrier_post((unsigned*)(a.ws + WS_CTL) + 4096, bst);
#ifndef PH
#define PH 0xFFF
#endif
#ifndef PROBE
#define PROBE 0
#endif
#define PHASE_BEGIN() unsigned char* ws = a.ws; int G = gridDim.x, bx = blockIdx.x; asm volatile("" : "+s"(ws), "+s"(G), "+s"(bx))
    if (PH & 1) prologue(a, lds);
    if (PROBE == 5) { __syncthreads(); prologue(a, lds); }
    if (a.ws == nullptr) grid.sync();
    xcd_barrier(xbar);

    for (int l = 0; l < DEPTH; ++l) {
        const bool last = (l == DEPTH - 1);
        const int Mff = last ? ML : MT;
        if (PH & 2) { PHASE_BEGIN(); (void)G; (void)bx;
            const float* modl = (const float*)(ws + WS_MOD) + (size_t)l * 9 * NMOD; float* X = (float*)(ws + WS_X); bf16_t* H = (bf16_t*)(ws + WS_H);
            const float* cp = (const float*)(ws + WS_CP);
            if (l == 0) norm_phase(a.in[0], a.in[2], X, cp + CP_AN, modl, 0, 1024, H, MT);
            else        norm_phase(X, X + (size_t)ML * DM, nullptr, cp + CP_AN + l * DM, modl, 0, 1024, H, MT, gridDim.x == 256 ? (const bf16_t*)(ws + WS_PB) : (const bf16_t*)nullptr); }
        xcd_barrier(xbar); if (PROBE == 4) xcd_barrier(xbar);
        if (PH & 4) { PHASE_BEGIN();
          pg8::Gemm g{(bf16_t*)(ws + WS_H), (bf16_t*)(ws + WS_WIN) + (size_t)l * DPROJ * DM, MT, DPROJ, DM}; pg8::StaticOrder S; S.init(MT, DPROJ, G, bx);
          const float* cosT = (const float*)(ws + WS_ROPE);
          EpiQKV E{(bf16_t*)(ws + WS_Q), (bf16_t*)(ws + WS_K), (bf16_t*)(ws + WS_V), (const float*)(ws + WS_GAIN) + l * 128, cosT, cosT + SEQ * 32};
          pg8::gemm_phase<EpiQKV, pg8::StaticOrder, true, true>(lds, g, S, E);
          if (PROBE == 2) { xcd_barrier(xbar); pg8::gemm_phase<EpiQKV, pg8::StaticOrder, true, true>(lds, g, S, E); } }
        xcd_barrier(xbar); if (PROBE == 4) xcd_barrier(xbar);
        if (PH & 8) { PHASE_BEGIN(); (void)G; (void)bx;
          const float* cp = (const float*)(ws + WS_CP);
          AttnP P{(bf16_t*)(ws + WS_Q), (bf16_t*)(ws + WS_O), (bf16_t*)(ws + WS_K), (bf16_t*)(ws + WS_V), cp + CP_RPB + l * 4 * 465, cp + CP_SINK + l * 4, (unsigned*)(ws + WS_CTL) + 64 * l, last ? 1024 : 1152, *((const float*)(ws + WS_GAIN) + 512 + l), (unsigned*)(ws + WS_CTL) + 2048 + 64 * l};
          attn_phase(lds, P);
          if (PROBE == 1) { xcd_barrier(xbar); AttnP P2 = P; P2.counter = (unsigned*)(ws + WS_CTL) + 64 * (l + 4); attn_phase(lds, P2); } }
        xcd_barrier(xbar); if (PROBE == 4) xcd_barrier(xbar);
        if (PH & 16) { PHASE_BEGIN();
          pg8::Gemm g{(bf16_t*)(ws + WS_O), (bf16_t*)(ws + WS_WOUT) + (size_t)l * DM * DM, Mff, DM, DM}; pg8::SplitCtxOrder S; S.init(Mff, DM, G, bx);
          EpiRes E{(float*)(ws + WS_X), (l == 0 && G == 256) ? a.in[0] : (const float*)(ws + WS_X), (const float*)(ws + WS_MOD) + (size_t)l * 9 * NMOD, 2048, (bf16_t*)(ws + WS_PB)};
          pg8::gemm_phase<EpiRes, pg8::SplitCtxOrder, true, true>(lds, g, S, E); }
        xcd_barrier(xbar); if (PROBE == 4) xcd_barrier(xbar);
        if (PH & 32) { PHASE_BEGIN(); (void)G; (void)bx;
            const float* modl = (const float*)(ws + WS_MOD) + (size_t)l * 9 * NMOD; float* X = (float*)(ws + WS_X);
            const float* cp = (const float*)(ws + WS_CP);
            norm_phase(X, X + (size_t)ML * DM, nullptr, cp + CP_FN + l * DM, modl, 3072, 4096, (bf16_t*)(ws + WS_H), Mff, (last || gridDim.x != 256) ? (const bf16_t*)nullptr : (const bf16_t*)(ws + WS_PB)); }
        xcd_barrier(xbar); if (PROBE == 4) xcd_barrier(xbar);
        if (PH & 64) { PHASE_BEGIN();
          pg8::Gemm g{(bf16_t*)(ws + WS_H), (bf16_t*)(ws + WS_WUP) + (size_t)l * 2 * DFF * DM, Mff, 2 * DFF, DM}; pg8::StaticOrder S; S.init(Mff, 2 * DFF, G, bx);
          const float* cp = (const float*)(ws + WS_CP) + CP_CONV;
          EpiUp E{(bf16_t*)(ws + WS_HID), (float*)(ws + WS_EDGE), cp + (size_t)l * 4 * DFF, cp + (size_t)l * 4 * DFF + 3 * DFF};
          pg8::gemm_phase<EpiUp, pg8::StaticOrder, true, true>(lds, g, S, E);
          if (PROBE == 3) { xcd_barrier(xbar); pg8::gemm_phase<EpiUp, pg8::StaticOrder, true, true>(lds, g, S, E); } }
        xcd_barrier(xbar); if (PROBE == 4) xcd_barrier(xbar);
        if (PH & 256) { PHASE_BEGIN();
          pg8::Gemm g{(bf16_t*)(ws + WS_HID), (bf16_t*)(ws + WS_WDN) + (size_t)l * DM * DFF, Mff, DM, DFF}; pg8::SplitCtxOrder S; S.init(Mff, DFF, G, bx);
          EpiRes E{(float*)(ws + WS_X), (const float*)(ws + WS_X), (const float*)(ws + WS_MOD) + (size_t)l * 9 * NMOD, 5120, (bf16_t*)(ws + WS_PB)};
          { const float* cpc = (const float*)(ws + WS_CP) + CP_CONV + (size_t)l * 4 * DFF; pg8::Unit fu;
            for (int i = 0; S.next(i, fu); ++i) fixup_tile((const float*)(ws + WS_EDGE), cpc, (bf16_t*)(ws + WS_HID), 4 * fu.pm);
            __syncthreads(); }
          pg8::gemm_phase<EpiRes, pg8::SplitCtxOrder, true, true>(lds, g, S, E); }
        xcd_barrier(xbar); if (PROBE == 4) xcd_barrier(xbar);
    }
    if (PH & 512) { PHASE_BEGIN(); (void)G; (void)bx; final_norm_phase((const float*)(ws + WS_X), (const float*)(ws + WS_CP) + CP_FIN, a.out); }
}

extern "C" void kernel_launch(void* const* d_in, const int* in_sizes, int n_in, void* d_out, int out_size, void* d_ws, size_t ws_size, hipStream_t stream) {
    static int grid = 0;
    if (grid == 0) {
        if (n_in != 19 || ws_size < WS_END) { fprintf(stderr, "kernel_launch: unexpected n_in %d or ws_size %zu (< %zu)\n", n_in, ws_size, (size_t)WS_END); grid = -1; return; }
        int dev = 0, cus = 0, per_cu = 0;
        (void)hipGetDevice(&dev);
        (void)hipDeviceGetAttribute(&cus, hipDeviceAttributeMultiprocessorCount, dev);
        if (hipFuncSetAttribute((const void*)mega_fwd, hipFuncAttributeMaxDynamicSharedMemorySize, LDS_BYTES) != hipSuccess) fprintf(stderr, "kernel_launch: hipFuncSetAttribute failed\n");
        if (hipOccupancyMaxActiveBlocksPerMultiprocessor(&per_cu, (const void*)mega_fwd, 512, LDS_BYTES) != hipSuccess || per_cu < 1) { fprintf(stderr, "kernel_launch: occupancy query says %d\n", per_cu); per_cu = 1; }
        (void)hipGetLastError();
        grid = cus * per_cu;
        fprintf(stderr, "kernel_launch: grid %d (cus %d x %d)\n", grid, cus, per_cu);
    }
    if (grid < 0) return;
    (void)hipMemsetAsync(d_ws, 0, 65536, stream);
    Args a{};
    for (int i = 0; i < 19; ++i) a.in[i] = (const float*)d_in[i];
    a.out = (float*)d_out; a.ws = (unsigned char*)d_ws;
    void* args[] = {&a};
    hipError_t e = hipLaunchCooperativeKernel((const void*)mega_fwd, dim3(grid), dim3(512), args, LDS_BYTES, stream);
    if (e != hipSuccess) fprintf(stderr, "kernel_launch: cooperative launch failed: %s (grid %d)\n", hipGetErrorString(e), grid);
}
```
